# Optimizing an MI355X kernel written in HIP

```python
import jax, jax.numpy as jnp
from jax import lax
import numpy as np

D_MODEL = 2048
BATCH = 4
SEQ = 2048
DEPTH = 2

CTX_LEN = 256
GRID_W = 64
HEAD_DIM = 128
ATT_W = (3 * D_MODEL) // 4
N_Q_HEADS = ATT_W // HEAD_DIM
N_KV_HEADS = 4
Q_PER_KV = N_Q_HEADS // N_KV_HEADS
KV_W = N_KV_HEADS * HEAD_DIM
FNET_W = D_MODEL // 4
N_FNET_GROUPS = 4
FNET_GROUP = FNET_W // N_FNET_GROUPS
ROPE_THETA = 10000.0
ROPE_AXIS_DIM = HEAD_DIM // 2
ROPE_NFREQ = ROPE_AXIS_DIM // 2
Q_BLOCK = 128
EPS = 1e-6

OFF_Q = 0
OFF_K = OFF_Q + ATT_W
OFF_V = OFF_K + KV_W
OFF_ZA = OFF_V + KV_W
OFF_UB = OFF_ZA + ATT_W
OFF_ZB = OFF_UB + FNET_W
OFF_GA = OFF_ZB + FNET_W
OFF_GB = OFF_GA + D_MODEL
IN_W = OFF_GB + D_MODEL
R_ZA = 0
R_UB = OFF_UB - OFF_ZA
R_ZB = OFF_ZB - OFF_ZA
R_GA = OFF_GA - OFF_ZA
R_GB = OFF_GB - OFF_ZA

kernel_name = "hybrid_gqa_fnet_gated_dit_block"


def _rmsnorm(x, g):
    xf = x.astype(jnp.float32)
    y = xf * lax.rsqrt(jnp.mean(xf * xf, axis=-1, keepdims=True) + EPS)
    return (y * g.astype(jnp.float32)).astype(x.dtype)


def _modulate(h, shift, scale):
    return h * (1 + scale) + shift


def _heads(p, lo, n_heads):
    b, n, _ = p.shape
    return p[..., lo:lo + n_heads * HEAD_DIM].reshape(b, n, n_heads, HEAD_DIM)


def _axial_rope_tables(n_tokens):
    rows = n_tokens // GRID_W
    row_pos = jnp.repeat(jnp.arange(rows, dtype=jnp.float32), GRID_W)
    col_pos = jnp.tile(jnp.arange(GRID_W, dtype=jnp.float32), rows)
    inv = ROPE_THETA ** (-jnp.arange(ROPE_NFREQ, dtype=jnp.float32) / ROPE_NFREQ)
    ang = jnp.stack([row_pos[:, None] * inv, col_pos[:, None] * inv], axis=1)
    return jnp.cos(ang), jnp.sin(ang)


def _rope(x, cos, sin):
    b, n, h, _ = x.shape
    xf = x.astype(jnp.float32).reshape(b, n, h, 2, 2, ROPE_NFREQ)
    x1, x2 = xf[..., 0, :], xf[..., 1, :]
    cc, ss = cos[None, :, None], sin[None, :, None]
    out = jnp.stack([x1 * cc - x2 * ss, x2 * cc + x1 * ss], axis=-2)
    return out.reshape(b, n, h, HEAD_DIM).astype(x.dtype)


def _attention(q, k, v):
    b, n = q.shape[:2]
    nblk = n // Q_BLOCK
    qb = q.reshape(b, nblk, Q_BLOCK, N_KV_HEADS, Q_PER_KV, HEAD_DIM).transpose(1, 0, 2, 3, 4, 5)

    def block(qi):
        s = jnp.einsum('bqhgd,bkhd->bhgqk', qi, k, preferred_element_type=jnp.float32)
        w = jax.nn.softmax(s, axis=-1).astype(v.dtype)
        return jnp.einsum('bhgqk,bkhd->bqhgd', w, v)

    o = lax.map(block, qb)
    return o.transpose(1, 0, 2, 3, 4, 5).reshape(b, n, ATT_W)


def _fourier_mix(u):
    b, n, _ = u.shape
    ug = u.astype(jnp.float32).reshape(b, n, N_FNET_GROUPS, FNET_GROUP)
    y = jnp.fft.fftn(ug, axes=(1, 3), norm="ortho").real
    return y.reshape(b, n, FNET_W).astype(u.dtype)


def _merge(p_rest, attn, w_pa, w_pb, w_o):
    z_a = p_rest[..., R_ZA:R_UB]
    u_b = p_rest[..., R_UB:R_ZB]
    z_b = p_rest[..., R_ZB:R_GA]
    g_a = jax.nn.sigmoid(p_rest[..., R_GA:R_GB])
    g_b = jax.nn.sigmoid(p_rest[..., R_GB:])
    y_a = (attn * jax.nn.silu(z_a)) @ w_pa
    y_b = (_fourier_mix(u_b) * jax.nn.silu(z_b)) @ w_pb
    return (g_a * y_a + g_b * y_b) @ w_o


def setup_inputs(seed: int = 0) -> dict:
    key = jax.random.key(seed)
    ks = jax.random.split(key, 16)
    f32 = jnp.float32
    nrm = lambda k, shape, s: jax.random.normal(k, shape, f32) * s
    return {
        "x": nrm(ks[0], (BATCH, SEQ, D_MODEL), 1.0),
        "c": nrm(ks[1], (BATCH, D_MODEL), 1.0),
        "ctx": nrm(ks[2], (BATCH, CTX_LEN, D_MODEL), 1.0),
        "c_ctx": nrm(ks[3], (D_MODEL,), 1.0),
        "w_ada": nrm(ks[4], (DEPTH, D_MODEL, 3 * D_MODEL), D_MODEL ** -0.5),
        "b_ada": nrm(ks[5], (DEPTH, 3 * D_MODEL), 0.01),
        "norm_g": 1.0 + nrm(ks[6], (DEPTH, D_MODEL), 0.01),
        "w_in": nrm(ks[7], (DEPTH, D_MODEL, IN_W), D_MODEL ** -0.5),
        "q_norm_g": 1.0 + nrm(ks[8], (DEPTH, HEAD_DIM), 0.01),
        "k_norm_g": 1.0 + nrm(ks[9], (DEPTH, HEAD_DIM), 0.01),
        "w_proj_a": nrm(ks[10], (DEPTH, ATT_W, D_MODEL), ATT_W ** -0.5),
        "w_proj_b": nrm(ks[11], (DEPTH, FNET_W, D_MODEL), FNET_W ** -0.5),
        "w_out": nrm(ks[12], (DEPTH, D_MODEL, D_MODEL), D_MODEL ** -0.5),
        "final_g": 1.0 + nrm(ks[13], (D_MODEL,), 0.01),
    }


def reference(x, c, ctx, c_ctx, w_ada, b_ada, norm_g, w_in, q_norm_g, k_norm_g,
              w_proj_a, w_proj_b, w_out, final_g):
    n_lat = x.shape[1]
    cos, sin = _axial_rope_tables(n_lat)
    q_scale = HEAD_DIM ** -0.5
    silu_c = jax.nn.silu(c)
    silu_cc = jax.nn.silu(c_ctx)
    xs, cs = x, ctx
    for l in range(DEPTH):
        last = l == DEPTH - 1
        w_l = w_in[l]
        shift, scale, gate = jnp.split(silu_c @ w_ada[l] + b_ada[l], 3, axis=-1)
        shift_c, scale_c, gate_c = jnp.split(silu_cc @ w_ada[l] + b_ada[l], 3, axis=-1)
        h = _modulate(_rmsnorm(xs, norm_g[l]), shift[:, None], scale[:, None])
        hc = _modulate(_rmsnorm(cs, norm_g[l]), shift_c, scale_c)

        pc_kv = hc @ w_l[:, OFF_K:OFF_ZA]
        kc = _rmsnorm(_heads(pc_kv, 0, N_KV_HEADS), k_norm_g[l])
        vc = _heads(pc_kv, KV_W, N_KV_HEADS)

        p = h @ w_l
        q = _rope(_rmsnorm(_heads(p, OFF_Q, N_Q_HEADS), q_norm_g[l]), cos, sin) * q_scale
        k = _rope(_rmsnorm(_heads(p, OFF_K, N_KV_HEADS), k_norm_g[l]), cos, sin)
        v = _heads(p, OFF_V, N_KV_HEADS)
        attn = _attention(q, jnp.concatenate([k, kc], axis=1), jnp.concatenate([v, vc], axis=1))
        y = _merge(p[..., OFF_ZA:], attn, w_proj_a[l], w_proj_b[l], w_out[l])
        new_xs = xs + gate[:, None] * y

        if not last:
            qc = _rmsnorm(_heads(hc @ w_l[:, OFF_Q:OFF_K], 0, N_Q_HEADS), q_norm_g[l]) * q_scale
            attn_c = _attention(qc, kc, vc)
            yc = _merge(hc @ w_l[:, OFF_ZA:], attn_c, w_proj_a[l], w_proj_b[l], w_out[l])
            cs = cs + gate_c * yc
        xs = new_xs
    return _rmsnorm(xs, final_g)
```

```cpp
#include <hip/hip_runtime.h>
#include <hip/hip_cooperative_groups.h>
#include <cstdio>
#include <cstdint>
namespace cg = cooperative_groups;

#ifndef MK_ONE_LAUNCH
#define MK_ONE_LAUNCH 1
#endif
#ifndef MK_XCD_BAR
#define MK_XCD_BAR 1
#endif
#ifndef PROBE_REP
#define PROBE_REP (-1)
#endif
#define NREP(k) ((k) == PROBE_REP ? 2 : 1)


#define LAS __attribute__((address_space(3)))
typedef unsigned short bf16_t;
typedef short bf16x8 __attribute__((ext_vector_type(8)));
typedef short s16x4 __attribute__((ext_vector_type(4)));
typedef float f32x4 __attribute__((ext_vector_type(4)));
typedef float f32x16 __attribute__((ext_vector_type(16)));
typedef unsigned u32x4 __attribute__((ext_vector_type(4)));
typedef unsigned u32x2 __attribute__((ext_vector_type(2)));

constexpr int DM = 2048, NB = 4, SEQ = 2048, CTX = 256;
constexpr int ML = NB * SEQ, MC = NB * CTX, MT = ML + MC;
constexpr int INW = 9216, KEYS = SEQ + CTX;
constexpr int NPH = 12;
constexpr float EPS = 1e-6f;

constexpr size_t MiB = 1u << 20;
constexpr size_t WS_MOD = 1 * MiB;
constexpr size_t WS_TAB = 2 * MiB;
constexpr size_t WS_TT = 2 * MiB + 512 * 1024;
constexpr size_t WS_DM = 3 * MiB;
constexpr size_t WS_WIN = 19 * MiB;
constexpr size_t WS_WCAT = 95 * MiB;
constexpr size_t WS_WO = 111 * MiB;
constexpr size_t WS_H = 127 * MiB;
constexpr size_t WS_Q = 163 * MiB;
constexpr size_t WS_K = 190 * MiB;
constexpr size_t WS_V = 199 * MiB;
constexpr size_t WS_ZA = 208 * MiB;
constexpr size_t WS_ZB = 235 * MiB;
constexpr size_t WS_GA = 244 * MiB;
constexpr size_t WS_GB = 280 * MiB;
constexpr size_t WS_UT = 316 * MiB;
constexpr size_t WS_UTC = 332 * MiB;
constexpr size_t WS_WUB = 334 * MiB;
constexpr size_t WS_XS = 338 * MiB;
constexpr size_t WS_AA = 338 * MiB;
constexpr size_t WS_AB = 361 * MiB;
constexpr size_t WS_ACAT = 370 * MiB;
constexpr size_t WS_MM = 406 * MiB;
constexpr size_t WS_CS1 = 442 * MiB;
constexpr size_t WS_PART = 450 * MiB;
constexpr size_t WS_END = 514 * MiB;

constexpr int LDS_BYTES = 147456;
constexpr int LDS_X = 131072;
constexpr int LDS_MISC = 131072 + 8192;
constexpr int CW_CTXCNT = 3520;
constexpr size_t CTL_ZERO_BYTES = 16384;

__device__ __forceinline__ unsigned cvt_pk_bf16(float lo, float hi) { unsigned r; asm volatile("v_cvt_pk_bf16_f32 %0, %1, %2" : "=v"(r) : "v"(lo), "v"(hi)); return r; }
__device__ __forceinline__ float bf_lo(unsigned w) { return __uint_as_float(w << 16); }
__device__ __forceinline__ float bf_hi(unsigned w) { return __uint_as_float(w & 0xffff0000u); }
__device__ __forceinline__ float bf2f(bf16_t v) { return __uint_as_float((unsigned)v << 16); }
__device__ __forceinline__ unsigned f2bf(float f) { unsigned u = __builtin_bit_cast(unsigned, f); return (u + 0x7fffu + ((u >> 16) & 1u)) >> 16; }
__device__ __forceinline__ float sigmoidf_(float x) { return __builtin_amdgcn_rcpf(1.f + __builtin_amdgcn_exp2f(-1.4426950408889634f * x)); }
__device__ __forceinline__ int ufl(int v) { return __builtin_amdgcn_readfirstlane(v); }
__device__ __forceinline__ size_t ufl64(size_t v) { const unsigned lo = __builtin_amdgcn_readfirstlane((unsigned)v), hi = __builtin_amdgcn_readfirstlane((unsigned)(v >> 32)); return ((size_t)hi << 32) | lo; }
__device__ __forceinline__ float wave_sum(float v) {
#pragma unroll
    for (int o = 1; o < 64; o <<= 1) v += __shfl_xor(v, o);
    return v;
}

namespace pg8 {
constexpr int BM = 256, BK = 64, HALF = 128, HTB = HALF * BK * 2, STAGE_BYTES = 8 * HTB;
__host__ __device__ __forceinline__ int lds_byte(int r, int c) { const int st = (r >> 4) * 2 + (c >> 5), rr = r & 15, cc = c & 31, ob = rr * 64 + cc * 2; return st * 1024 + (ob ^ (((ob >> 9) & 1) << 5)); }
__host__ __device__ __forceinline__ void stage_rc(int b, int& R, int& C) { const int st = b / 1024, sb = b % 1024, swz = sb ^ (((sb >> 9) & 1) << 5); R = (st >> 1) * 16 + swz / 64; C = (st & 1) * 32 + (swz % 64) / 2; }
__host__ __device__ __forceinline__ int perm32(int rho) { const int n = rho >> 4, i = rho & 15; return 8 * (i >> 2) + 4 * n + (i & 3); }

struct Unit { int kind, pm, pn, nt; const char* a; const char* b; };

__device__ __forceinline__ void tile_decode(int L, int nM, int nN, int& pm, int& pn) {
    const int nwg = nM * nN; int wgid = L;
    { const int q = nwg / 8, r = nwg % 8, xcd = wgid % 8, off = wgid / 8; wgid = (xcd < r ? xcd * (q + 1) : r * (q + 1) + (xcd - r) * q) + off; }
    const int nig = 8 * nN, gid = wgid / nig, fm = gid * 8, gsz = (nM - fm) < 8 ? (nM - fm) : 8;
    pm = fm + ((wgid % nig) % gsz); pn = (wgid % nig) / gsz;
}

template <class Epi, class Sched>
__device__ __forceinline__ void gemm_phase(LAS unsigned char* lds, const int K, const Sched& S, const Epi& E) {
    int tid = threadIdx.x; asm volatile("" : "+v"(tid));
    const int wid = __builtin_amdgcn_readfirstlane(tid >> 6), lane = tid & 63, wr = wid >> 2, wc = wid & 3, fr = lane & 15, fq = lane >> 4;
    unsigned voffA[2], voffB[2];
#pragma unroll
    for (int i = 0; i < 2; ++i) { int R, C; stage_rc(tid * 16 + i * 8192, R, C); const int Rb = (R & ~31) + perm32(R & 31);
        voffA[i] = (unsigned)(R * K + C) * 2u; voffB[i] = (unsigned)(Rb * K + C) * 2u; }
    const size_t kstep = (size_t)(BK * 2);
    const size_t hstep = (size_t)HALF * K * 2;
    const unsigned ldsw = (unsigned)wid * 1024u;
    const int aoff = lds_byte(wr * 64 + fr, fq * 8), boff = lds_byte(wc * 32 + fr, fq * 8);
#define PG8_SA(b, h) (((b) * 2 + (h)) * HTB)
#define PG8_SB(b, h) ((4 + (b) * 2 + (h)) * HTB)
#define PG8_STAGE(bufoff, gbase, voff) do { _Pragma("unroll") for (int _i = 0; _i < 2; ++_i) \
        __builtin_amdgcn_global_load_lds((const unsigned*)((const char*)(gbase) + (voff)[_i]), (LAS unsigned*)(lds + (bufoff) + ldsw + _i * 8192), 16, 0, 0); } while (0)
#define PG8_LDA(dst, b, h) do { _Pragma("unroll") for (int m = 0; m < 4; ++m) _Pragma("unroll") for (int k = 0; k < 2; ++k) dst[m][k] = *(const LAS bf16x8*)(lds + PG8_SA(b, h) + aoff + m * 2048 + k * 1024); } while (0)
#define PG8_LDB(dst, b, h) do { _Pragma("unroll") for (int n = 0; n < 2; ++n) _Pragma("unroll") for (int k = 0; k < 2; ++k) dst[n][k] = *(const LAS bf16x8*)(lds + PG8_SB(b, h) + boff + n * 2048 + k * 1024); } while (0)
#define PG8_MMA(ai, bj, At, Bt) do { __builtin_amdgcn_s_setprio(1); _Pragma("unroll") for (int m = 0; m < 4; ++m) _Pragma("unroll") for (int n = 0; n < 2; ++n) _Pragma("unroll") for (int k = 0; k < 2; ++k) \
        acc[ai][bj][m][n] = __builtin_amdgcn_mfma_f32_16x16x32_bf16(Bt[n][k], At[m][k], acc[ai][bj][m][n], 0, 0, 0); __builtin_amdgcn_s_setprio(0); } while (0)
#define PG8_WAIT_V(n) asm volatile("s_waitcnt vmcnt(" #n ")" ::: "memory")
#define PG8_WAIT_L(n) asm volatile("s_waitcnt lgkmcnt(" #n ")" ::: "memory")
#define PG8_BAR __builtin_amdgcn_s_barrier()
#define PG8_SCHED __builtin_amdgcn_sched_barrier(0)
    Unit cur, nxt; int ui = 0;
    if (!S.next(0, cur)) return;
    f32x4 acc[2][2][4][2];
#pragma unroll
    for (int a = 0; a < 2; ++a)
#pragma unroll
        for (int b = 0; b < 2; ++b)
#pragma unroll
            for (int m = 0; m < 4; ++m)
#pragma unroll
                for (int n = 0; n < 2; ++n) acc[a][b][m][n] = (f32x4){0.f, 0.f, 0.f, 0.f};
    bf16x8 At[4][2], B0[2][2], B1[2][2];
    const char* cA = cur.a; const char* cB = cur.b;
    PG8_STAGE(PG8_SB(0, 0), cB, voffB); PG8_STAGE(PG8_SB(0, 1), cB + hstep, voffB); PG8_STAGE(PG8_SA(0, 0), cA, voffA); PG8_STAGE(PG8_SA(0, 1), cA + hstep, voffA);
    if (wr == 1) PG8_BAR;
    PG8_WAIT_V(2); PG8_BAR;
    PG8_STAGE(PG8_SB(1, 0), cB + kstep, voffB); PG8_STAGE(PG8_SA(1, 0), cA + kstep, voffA); PG8_STAGE(PG8_SB(1, 1), cB + hstep + kstep, voffB);
    PG8_WAIT_V(6); PG8_BAR;
    for (;;) {
        const bool has_next = S.next(ui + 1, nxt);
        const char* nA = has_next ? nxt.a : cA; const char* nB = has_next ? nxt.b : cB;
        const int nt = cur.nt;
        for (int t = 0; t < nt; t += 2) {
            if constexpr (Epi::HAS_MID) { if (t == Epi::MID_T) E.mid(acc, cur, wr, wc, fr, fq); }
            const bool last = (t == nt - 2);
            const char* a1 = cA + (size_t)(t + 1) * kstep;
            const char* a2 = last ? nA : cA + (size_t)(t + 2) * kstep; const char* b2 = last ? nB : cB + (size_t)(t + 2) * kstep;
            const char* a3 = a2 + kstep; const char* b3 = b2 + kstep;
            PG8_LDB(B0, 0, 0); PG8_LDB(B1, 0, 1); PG8_SCHED; PG8_LDA(At, 0, 0); PG8_STAGE(PG8_SA(1, 1), a1 + hstep, voffA);
            PG8_WAIT_V(8); PG8_WAIT_L(0); PG8_BAR; PG8_MMA(0, 0, At, B0); PG8_MMA(0, 1, At, B1); PG8_BAR; PG8_SCHED;
            PG8_LDA(At, 0, 1); PG8_STAGE(PG8_SB(0, 0), b2, voffB); PG8_STAGE(PG8_SB(0, 1), b2 + hstep, voffB); PG8_STAGE(PG8_SA(0, 0), a2, voffA);
            PG8_WAIT_V(8); PG8_WAIT_L(0); PG8_BAR; PG8_MMA(1, 0, At, B0); PG8_MMA(1, 1, At, B1); PG8_BAR; PG8_SCHED;
            PG8_LDB(B0, 1, 0); PG8_LDB(B1, 1, 1); PG8_SCHED; PG8_LDA(At, 1, 0); PG8_STAGE(PG8_SA(0, 1), a2 + hstep, voffA);
            PG8_WAIT_V(8); PG8_WAIT_L(0); PG8_BAR; PG8_MMA(0, 0, At, B0); PG8_MMA(0, 1, At, B1); PG8_BAR; PG8_SCHED;
            PG8_LDA(At, 1, 1); PG8_STAGE(PG8_SB(1, 0), b3, voffB); PG8_STAGE(PG8_SB(1, 1), b3 + hstep, voffB); PG8_STAGE(PG8_SA(1, 0), a3, voffA);
            PG8_WAIT_V(8); PG8_WAIT_L(0); PG8_BAR; PG8_MMA(1, 0, At, B0); PG8_MMA(1, 1, At, B1); PG8_BAR; PG8_SCHED;
        }
        if (wr == 0) PG8_BAR;
        E(acc, cur, wr, wc, fr, fq);
        if (!has_next) break;
#pragma unroll
        for (int a = 0; a < 2; ++a)
#pragma unroll
            for (int b = 0; b < 2; ++b)
#pragma unroll
                for (int m = 0; m < 4; ++m)
#pragma unroll
                    for (int n = 0; n < 2; ++n) acc[a][b][m][n] = (f32x4){0.f, 0.f, 0.f, 0.f};
        cur = nxt; cA = nA; cB = nB; ++ui;
        if (wr == 1) PG8_BAR;
    }
    PG8_WAIT_V(0);
    PG8_BAR;
#undef PG8_SA
#undef PG8_SB
#undef PG8_STAGE
#undef PG8_LDA
#undef PG8_LDB
#undef PG8_MMA
#undef PG8_WAIT_V
#undef PG8_WAIT_L
#undef PG8_BAR
#undef PG8_SCHED
}

typedef const f32x4 (&AccRef)[2][2][4][2];

__device__ __forceinline__ void epi_act(AccRef acc, bf16_t* O, int ld, int act, int wr, int wc, int fr, int fq) {
#pragma unroll
    for (int ai = 0; ai < 2; ++ai)
#pragma unroll
        for (int m = 0; m < 4; ++m) { bf16_t* rowp = O + (size_t)(ai * HALF + wr * 64 + m * 16 + fr) * ld + wc * 32 + 8 * fq;
#pragma unroll
            for (int bj = 0; bj < 2; ++bj) { f32x4 v0 = acc[ai][bj][m][0], v1 = acc[ai][bj][m][1];
                if (act != 0) {
#pragma unroll
                    for (int e = 0; e < 4; ++e) { const float s0 = sigmoidf_(v0[e]), s1 = sigmoidf_(v1[e]); v0[e] = act == 1 ? v0[e] * s0 : s0; v1[e] = act == 1 ? v1[e] * s1 : s1; } }
                u32x4 w; w.x = cvt_pk_bf16(v0[0], v0[1]); w.y = cvt_pk_bf16(v0[2], v0[3]); w.z = cvt_pk_bf16(v1[0], v1[1]); w.w = cvt_pk_bf16(v1[2], v1[3]);
                *(u32x4*)(rowp + bj * HALF) = w; }
            if (m & 1) asm volatile("" ::: "memory"); }
}
__device__ __forceinline__ void epi_qk(AccRef acc, bf16_t* O, int ld, const float* g, const float* rope, int tok0, LAS float* X, int wr, int wc, int fr, int fq) {
#pragma unroll
    for (int ai = 0; ai < 2; ++ai)
#pragma unroll
        for (int m = 0; m < 4; ++m)
#pragma unroll
            for (int bj = 0; bj < 2; ++bj) { const f32x4 a = acc[ai][bj][m][0], b = acc[ai][bj][m][1];
                float s = (a[0] * a[0] + a[1] * a[1]) + (a[2] * a[2] + a[3] * a[3]) + (b[0] * b[0] + b[1] * b[1]) + (b[2] * b[2] + b[3] * b[3]);
                s += __shfl_xor(s, 16); s += __shfl_xor(s, 32);
                if (fq == 0) X[((ai * HALF + wr * 64 + m * 16 + fr) * 2 + bj) * 4 + wc] = s; }
    asm volatile("s_waitcnt lgkmcnt(0)" ::: "memory"); __builtin_amdgcn_s_barrier(); asm volatile("" ::: "memory");
    const int axis = wc >> 1, f0 = (wc & 1) * 16 + 4 * fq;
    const f32x4 g1 = *(const f32x4*)(g + axis * 64 + f0), g2 = *(const f32x4*)(g + axis * 64 + 32 + f0);
#pragma unroll
    for (int ai = 0; ai < 2; ++ai)
#pragma unroll
        for (int m = 0; m < 4; ++m) { const int rowl = ai * HALF + wr * 64 + m * 16 + fr;
            f32x4 cs0 = (f32x4){1.f, 0.f, 1.f, 0.f}, cs1 = cs0;
            if (rope) { const int n = tok0 + rowl, pos = axis ? (n & 63) : (n >> 6); const float* p = rope + (pos * 32 + f0) * 2; cs0 = *(const f32x4*)p; cs1 = *(const f32x4*)(p + 4); }
            const float co[4] = {cs0[0], cs0[2], cs1[0], cs1[2]}, si[4] = {cs0[1], cs0[3], cs1[1], cs1[3]};
#pragma unroll
            for (int bj = 0; bj < 2; ++bj) { const f32x4 part = *(const LAS f32x4*)(X + (rowl * 2 + bj) * 4);
                const float rstd = __builtin_amdgcn_rsqf(((part[0] + part[1]) + (part[2] + part[3])) * (1.f / 128.f) + EPS);
                const f32x4 x1 = acc[ai][bj][m][0] * rstd * g1, x2 = acc[ai][bj][m][1] * rstd * g2; float o1[4], o2[4];
#pragma unroll
                for (int e = 0; e < 4; ++e) { o1[e] = x1[e] * co[e] - x2[e] * si[e]; o2[e] = x2[e] * co[e] + x1[e] * si[e]; }
                u32x4 w; w.x = cvt_pk_bf16(o1[0], o1[1]); w.y = cvt_pk_bf16(o1[2], o1[3]); w.z = cvt_pk_bf16(o2[0], o2[1]); w.w = cvt_pk_bf16(o2[2], o2[3]);
                *(u32x4*)(O + (size_t)rowl * ld + bj * HALF + wc * 32 + 8 * fq) = w; }
            asm volatile("" ::: "memory"); }
}
__device__ __forceinline__ void epi_mul(AccRef acc, bf16_t* O, int ldo, const bf16_t* A1, int ld, int wr, int wc, int fr, int fq) {
#pragma unroll
    for (int ai = 0; ai < 2; ++ai)
#pragma unroll
        for (int m = 0; m < 4; ++m) { const int rl = ai * HALF + wr * 64 + m * 16 + fr, cl = wc * 32 + 8 * fq;
#pragma unroll
            for (int bj = 0; bj < 2; ++bj) { const u32x4 q1 = *(const u32x4*)(A1 + (size_t)rl * ld + cl + bj * HALF);
                f32x4 v0 = acc[ai][bj][m][0], v1 = acc[ai][bj][m][1];
                v0[0] *= bf_lo(q1.x); v0[1] *= bf_hi(q1.x); v0[2] *= bf_lo(q1.y); v0[3] *= bf_hi(q1.y); v1[0] *= bf_lo(q1.z); v1[1] *= bf_hi(q1.z); v1[2] *= bf_lo(q1.w); v1[3] *= bf_hi(q1.w);
                u32x4 w; w.x = cvt_pk_bf16(v0[0], v0[1]); w.y = cvt_pk_bf16(v0[2], v0[3]); w.z = cvt_pk_bf16(v1[0], v1[1]); w.w = cvt_pk_bf16(v1[2], v1[3]);
                *(u32x4*)(O + (size_t)rl * ldo + cl + bj * HALF) = w; }
            if (m == 3) asm volatile("" ::: "memory"); }
}
__device__ __forceinline__ void epi_ratio(f32x4 (&acc)[2][2][4][2], const bf16_t* GAo, const bf16_t* GBo, int wr, int wc, int fr, int fq) {
#pragma unroll
    for (int ai = 0; ai < 2; ++ai)
#pragma unroll
        for (int m = 0; m < 4; ++m) { const size_t ro = (size_t)(ai * HALF + wr * 64 + m * 16 + fr) * DM + wc * 32 + 8 * fq;
#pragma unroll
            for (int bj = 0; bj < 2; ++bj) { const u32x4 qa = *(const u32x4*)(GAo + ro + bj * HALF), qb = *(const u32x4*)(GBo + ro + bj * HALF);
                f32x4& v0 = acc[ai][bj][m][0]; f32x4& v1 = acc[ai][bj][m][1];
                v0[0] *= bf_lo(qb.x) * __builtin_amdgcn_rcpf(bf_lo(qa.x)); v0[1] *= bf_hi(qb.x) * __builtin_amdgcn_rcpf(bf_hi(qa.x));
                v0[2] *= bf_lo(qb.y) * __builtin_amdgcn_rcpf(bf_lo(qa.y)); v0[3] *= bf_hi(qb.y) * __builtin_amdgcn_rcpf(bf_hi(qa.y));
                v1[0] *= bf_lo(qb.z) * __builtin_amdgcn_rcpf(bf_lo(qa.z)); v1[1] *= bf_hi(qb.z) * __builtin_amdgcn_rcpf(bf_hi(qa.z));
                v1[2] *= bf_lo(qb.w) * __builtin_amdgcn_rcpf(bf_lo(qa.w)); v1[3] *= bf_hi(qb.w) * __builtin_amdgcn_rcpf(bf_hi(qa.w)); }
            if (m == 3) asm volatile("" ::: "memory"); }
}
template <bool IN_BF>
__device__ __forceinline__ void epi_res(AccRef acc, bf16_t* O, const void* Xin, const float* gate, int wr, int wc, int fr, int fq) {
    f32x4 gv[2][2];
#pragma unroll
    for (int bj = 0; bj < 2; ++bj)
#pragma unroll
        for (int n = 0; n < 2; ++n) gv[bj][n] = *(const f32x4*)(gate + bj * HALF + wc * 32 + 8 * fq + 4 * n);
#pragma unroll
    for (int ai = 0; ai < 2; ++ai)
#pragma unroll
        for (int m = 0; m < 4; ++m) { const size_t ro = (size_t)(ai * HALF + wr * 64 + m * 16 + fr) * DM + wc * 32 + 8 * fq;
#pragma unroll
            for (int bj = 0; bj < 2; ++bj) { const size_t off = ro + bj * HALF; f32x4 x0, x1;
                if (IN_BF) { const u32x4 q = *(const u32x4*)((const bf16_t*)Xin + off); x0 = (f32x4){bf_lo(q.x), bf_hi(q.x), bf_lo(q.y), bf_hi(q.y)}; x1 = (f32x4){bf_lo(q.z), bf_hi(q.z), bf_lo(q.w), bf_hi(q.w)}; }
                else { x0 = *(const f32x4*)((const float*)Xin + off); x1 = *(const f32x4*)((const float*)Xin + off + 4); }
                const f32x4 o0 = x0 + gv[bj][0] * acc[ai][bj][m][0], o1 = x1 + gv[bj][1] * acc[ai][bj][m][1];
                u32x4 w; w.x = cvt_pk_bf16(o0[0], o0[1]); w.y = cvt_pk_bf16(o0[2], o0[3]); w.z = cvt_pk_bf16(o1[0], o1[1]); w.w = cvt_pk_bf16(o1[2], o1[3]);
                *(u32x4*)(O + off) = w; }
            if (m == 3) asm volatile("" ::: "memory"); }
}
__device__ __forceinline__ void epi_res_final(f32x4 (&acc)[2][2][4][2], const bf16_t* Xin, const float* gate, float* Fo, const float* fg, float* slots, unsigned* cnt, int pn, LAS float* PL, int wr, int wc, int fr, int fq) {
    int tid = threadIdx.x; asm volatile("" : "+v"(tid));
    const int wid = __builtin_amdgcn_readfirstlane(tid >> 6), lane = tid & 63;
    {   f32x4 gv[2][2];
#pragma unroll
        for (int bj = 0; bj < 2; ++bj)
#pragma unroll
            for (int n = 0; n < 2; ++n) gv[bj][n] = *(const f32x4*)(gate + bj * HALF + wc * 32 + 8 * fq + 4 * n);
#pragma unroll
        for (int ai = 0; ai < 2; ++ai)
#pragma unroll
            for (int m = 0; m < 4; ++m) { const size_t ro = (size_t)(ai * HALF + wr * 64 + m * 16 + fr) * DM + wc * 32 + 8 * fq; float s = 0.f;
#pragma unroll
                for (int bj = 0; bj < 2; ++bj) { const u32x4 q = *(const u32x4*)(Xin + ro + bj * HALF);
                    const f32x4 x0 = (f32x4){bf_lo(q.x), bf_hi(q.x), bf_lo(q.y), bf_hi(q.y)}, x1 = (f32x4){bf_lo(q.z), bf_hi(q.z), bf_lo(q.w), bf_hi(q.w)};
                    const f32x4 o0 = x0 + gv[bj][0] * acc[ai][bj][m][0], o1 = x1 + gv[bj][1] * acc[ai][bj][m][1];
                    acc[ai][bj][m][0] = o0; acc[ai][bj][m][1] = o1;
                    s += (o0[0] * o0[0] + o0[1] * o0[1]) + (o0[2] * o0[2] + o0[3] * o0[3]) + (o1[0] * o1[0] + o1[1] * o1[1]) + (o1[2] * o1[2] + o1[3] * o1[3]); }
                s += __shfl_xor(s, 16); s += __shfl_xor(s, 32);
                if (fq == 0) PL[(ai * HALF + wr * 64 + m * 16 + fr) * 4 + wc] = s;
                if (m == 3) asm volatile("" ::: "memory"); }
    }
    asm volatile("s_waitcnt lgkmcnt(0)" ::: "memory"); __builtin_amdgcn_s_barrier(); asm volatile("" ::: "memory");
    const int row = wid * 32 + (lane & 31);
    if (lane < 32) { const f32x4 p = *(const LAS f32x4*)(PL + row * 4); __hip_atomic_store(slots + row * 8 + pn, (p[0] + p[1]) + (p[2] + p[3]), __ATOMIC_RELAXED, __HIP_MEMORY_SCOPE_AGENT); }
    asm volatile("s_waitcnt vmcnt(0)" ::: "memory");
    if (lane == 0) (void)__hip_atomic_fetch_add(cnt, 1u, __ATOMIC_RELAXED, __HIP_MEMORY_SCOPE_AGENT);
    if (wid == 0) { unsigned sp = 0;
        while ((unsigned)__builtin_amdgcn_readfirstlane(__hip_atomic_load(cnt, __ATOMIC_RELAXED, __HIP_MEMORY_SCOPE_AGENT)) < 64u) { __builtin_amdgcn_s_sleep(2); if (++sp > (1u << 21)) break; }
        __builtin_amdgcn_fence(__ATOMIC_ACQUIRE, "agent"); }
    asm volatile("s_waitcnt vmcnt(0) lgkmcnt(0)" ::: "memory"); __builtin_amdgcn_s_barrier(); asm volatile("" ::: "memory");
    if (lane < 32) { float t = 0.f;
#pragma unroll
        for (int k = 0; k < 8; ++k) t += __hip_atomic_load(slots + row * 8 + k, __ATOMIC_RELAXED, __HIP_MEMORY_SCOPE_AGENT);
        PL[1024 + row] = __builtin_amdgcn_rsqf(t * (1.f / DM) + EPS); }
    asm volatile("s_waitcnt vmcnt(0) lgkmcnt(0)" ::: "memory"); __builtin_amdgcn_s_barrier(); asm volatile("" ::: "memory");
    {   f32x4 gf[2][2];
#pragma unroll
        for (int bj = 0; bj < 2; ++bj)
#pragma unroll
            for (int n = 0; n < 2; ++n) gf[bj][n] = *(const f32x4*)(fg + bj * HALF + wc * 32 + 8 * fq + 4 * n);
#pragma unroll
        for (int ai = 0; ai < 2; ++ai)
#pragma unroll
            for (int m = 0; m < 4; ++m) { const int rl = ai * HALF + wr * 64 + m * 16 + fr; const float rstd = PL[1024 + rl]; float* op = Fo + (size_t)rl * DM + wc * 32 + 8 * fq;
#pragma unroll
                for (int bj = 0; bj < 2; ++bj)
#pragma unroll
                    for (int n = 0; n < 2; ++n) *(f32x4*)(op + bj * HALF + 4 * n) = acc[ai][bj][m][n] * rstd * gf[bj][n]; }
    }
}
}

enum { KQ = 0, KK = 1, KACT = 2, KUB = 3 };
struct G1Sched {
    int Gq, cq, nM, nA, n1, n2, Lbase, Lend, split; const char* H; const char* W;
    __device__ __forceinline__ bool next(int i, pg8::Unit& u) const {
        if (cq < 0 || cq >= Gq) return false;
        int L = Lbase + i * Gq + cq; if (L >= Lend) return false;
        u.nt = DM / 64;
        if (L < nA) { int pm, j; pg8::tile_decode(L, nM, 18, pm, j); const int pn = ufl(j < 16 ? j : j + 4); pm = ufl(pm);
            u.kind = pn < 6 ? KQ : (pn < 8 ? KK : KACT); u.pm = pm; u.pn = pn; u.a = H + (size_t)pm * MiB; u.b = W + (size_t)pn * MiB; return true; }
        L -= nA;
        if (L < n1) { int pc, tt; pg8::tile_decode(L, 4, nM, pc, tt); pc = ufl(pc); tt = ufl(tt); u.kind = KUB; u.pm = pc; u.pn = tt; u.a = W + (size_t)(16 + pc) * MiB; u.b = H + (size_t)tt * MiB; return true; }
        L -= n1;
        if (L < n2) { const int pm = 32 + (L & 3), pn = 6 + (L >> 2); u.kind = pn < 8 ? KK : KACT; u.pm = pm; u.pn = pn; u.a = H + (size_t)pm * MiB; u.b = W + (size_t)pn * MiB; return true; }
        L -= n2;
        int pm, j, pn;
        if (!split) { pg8::tile_decode(L, nM, 16, pm, j); pn = 22 + j; }
        else if (L < (nM - 6) * 16) { pg8::tile_decode(L, nM - 6, 16, pm, j); pm += 6; pn = 22 + j; }
        else if (L < (nM - 6) * 16 + 8) { pm = 5; pn = 22 + (L - (nM - 6) * 16); }
        else if (L < (nM - 6) * 16 + 8 + 80) { pg8::tile_decode(L - (nM - 6) * 16 - 8, 5, 16, pm, j); pn = 22 + j; }
        else { pm = 5; pn = 30 + (L - (nM - 6) * 16 - 88); }
        pm = ufl(pm); pn = ufl(pn); u.kind = KACT; u.pm = pm; u.pn = pn; u.a = H + (size_t)pm * MiB; u.b = W + (size_t)pn * MiB; return true;
    }
};
struct G1Epi {
    static constexpr bool HAS_MID = false; static constexpr int MID_T = 0;
    unsigned char* ws; const float *qg, *kg; LAS float* X;
    __device__ __forceinline__ void operator()(pg8::AccRef acc, const pg8::Unit& u, int wr, int wc, int fr, int fq) const {
        asm volatile("" : "+v"(fr), "+v"(fq));
        const int pm = u.pm, pn = u.pn; const float* rope = (const float*)(ws + WS_TAB);
        if (u.kind == KQ) {
            pg8::epi_qk(acc, (bf16_t*)(ws + WS_Q) + (size_t)pm * 256 * 1536 + pn * 256, 1536, qg, pm < 32 ? rope : nullptr, (pm & 7) * 256, X, wr, wc, fr, fq);
        } else if (u.kind == KK) {
            const int kvrow0 = pm < 32 ? pm * 256 + (pm >> 3) * 256 : (pm - 32) * KEYS + SEQ;
            pg8::epi_qk(acc, (bf16_t*)(ws + WS_K) + (size_t)kvrow0 * 512 + (pn - 6) * 256, 512, kg, pm < 32 ? rope : nullptr, (pm & 7) * 256, X, wr, wc, fr, fq);
        } else {
            bf16_t* O; int ld, act = 0;
            if (u.kind == KUB) { const int cs = pm >> 1, chb = (pm & 1) * 256;
                if (pn < 32) { O = (bf16_t*)(ws + WS_UT) + ((size_t)((pn >> 3) * 512 + chb)) * 4096 + cs * 2048 + (pn & 7) * 256; ld = 4096; }
                else { O = (bf16_t*)(ws + WS_UTC) + ((size_t)((pn - 32) * 512 + chb)) * 512 + cs * 256; ld = 512; } }
            else if (pn < 10) { const int kvrow0 = pm < 32 ? pm * 256 + (pm >> 3) * 256 : (pm - 32) * KEYS + SEQ; O = (bf16_t*)(ws + WS_V) + (size_t)kvrow0 * 512 + (pn - 8) * 256; ld = 512; }
            else if (pn < 16) { O = (bf16_t*)(ws + WS_ZA) + (size_t)pm * 256 * 1536 + (pn - 10) * 256; ld = 1536; act = 1; }
            else if (pn < 22) { O = (bf16_t*)(ws + WS_ZB) + (size_t)pm * 256 * 512 + (pn - 20) * 256; ld = 512; act = 1; }
            else if (pn < 30) { O = (bf16_t*)(ws + WS_GA) + (size_t)pm * 256 * 2048 + (pn - 22) * 256; ld = 2048; act = 2; }
            else { O = (bf16_t*)(ws + WS_GB) + (size_t)pm * 256 * 2048 + (pn - 30) * 256; ld = 2048; act = 2; }
            pg8::epi_act(acc, O, ld, act, wr, wc, fr, fq);
        }
    }
};
struct GridSched {
    int G, c, nM, nN, nt; const char* A; const char* B; size_t astep, bstep;
    __device__ __forceinline__ bool next(int i, pg8::Unit& u) const {
        const int L = i * G + c; if (L >= nM * nN) return false;
        int pm, pn; pg8::tile_decode(L, nM, nN, pm, pn); pm = ufl(pm); pn = ufl(pn); u.kind = 0; u.nt = nt; u.pm = pm; u.pn = pn; u.a = A + (size_t)pm * astep; u.b = B + (size_t)pn * bstep; return true;
    }
};
struct FnSched {
    int G, c, cu0, nunits, ntn, nt; const char* A; const char* B; size_t astep, bstep, bbatch; int row_base, rows_per_b;
    __device__ __forceinline__ bool next(int i, pg8::Unit& u) const {
        const int L = ufl(i * G + ((c - cu0 + 4 * G) % G)); if (L >= nunits) return false;
        const int pn = L & 1, pmn = ufl((L >> 1) % ntn), b = ufl((L >> 1) / ntn);
        u.kind = 0; u.nt = nt; u.pm = row_base + b * rows_per_b + pmn * 256;   u.pn = pn; u.a = A + (size_t)pmn * astep; u.b = B + (size_t)b * bbatch + (size_t)pn * bstep; return true;
    }
};
struct FnEpi {
    static constexpr bool HAS_MID = false; static constexpr int MID_T = 0;
    bf16_t* ACAT; const bf16_t* ZB;
    __device__ __forceinline__ void operator()(pg8::AccRef acc, const pg8::Unit& u, int wr, int wc, int fr, int fq) const {
        asm volatile("" : "+v"(fr), "+v"(fq));
        pg8::epi_mul(acc, ACAT + (size_t)u.pm * DM + u.pn * 256, DM, ZB + (size_t)u.pm * 512 + u.pn * 256, 512, wr, wc, fr, fq);
    }
};
struct M1Epi {
    static constexpr bool HAS_MID = true; static constexpr int MID_T = 8;
    bf16_t* MMo; const bf16_t* GA; const bf16_t* GB;
    __device__ __forceinline__ void mid(f32x4 (&acc)[2][2][4][2], const pg8::Unit& u, int wr, int wc, int fr, int fq) const {
        asm volatile("" : "+v"(fr), "+v"(fq));
        const size_t o = (size_t)u.pm * 256 * DM + u.pn * 256; pg8::epi_ratio(acc, GA + o, GB + o, wr, wc, fr, fq);
    }
    __device__ __forceinline__ void operator()(pg8::AccRef acc, const pg8::Unit& u, int wr, int wc, int fr, int fq) const {
        asm volatile("" : "+v"(fr), "+v"(fq));
        const size_t o = (size_t)u.pm * 256 * DM + u.pn * 256; pg8::epi_mul(acc, MMo + o, DM, GA + o, DM, wr, wc, fr, fq);
    }
};
struct CtxM1Sched {
    int cq; const char* A; const char* B;
    __device__ __forceinline__ bool next(int i, pg8::Unit& u) const {
        if (i > 0 || cq < 0 || cq >= 32) return false;
        u.kind = 0; u.nt = 32; u.pm = 32 + (cq >> 3); u.pn = cq & 7; u.a = A + (size_t)u.pm * MiB; u.b = B + (size_t)u.pn * MiB; return true;
    }
};
struct FoldSched {
    int G, c; const char* Tt; const char* Wub;
    __device__ __forceinline__ bool next(int i, pg8::Unit& u) const {
        const int L = i * G + c; if (L >= 64) return false;
        int two = 2; asm volatile("" : "+s"(two));
        u.kind = 0; u.nt = two; u.pm = L >> 3; u.pn = L & 7; u.a = Tt; u.b = Wub + (size_t)(L >> 3) * (512 * 1024) + (size_t)(L & 7) * 65536; return true;
    }
};
struct FoldEpi {
    static constexpr bool HAS_MID = false; static constexpr int MID_T = 0;
    unsigned char* ws;
    __device__ __forceinline__ void operator()(pg8::AccRef acc, const pg8::Unit& u, int wr, int wc, int fr, int fq) const {
        asm volatile("" : "+v"(fr), "+v"(fq));
        const int l2 = u.pm >> 2, g = u.pm & 3; bf16_t* WT = (bf16_t*)(ws + WS_WIN + (size_t)l2 * 38 * MiB) + (size_t)(4096 + g * 128) * DM + u.pn * 256;
#pragma unroll
        for (int ai = 0; ai < 2; ++ai)
#pragma unroll
            for (int m = 0; m < 4; ++m) { bf16_t* rowp = WT + (size_t)(ai * 512 + wr * 64 + m * 16 + fr) * DM + wc * 32 + 8 * fq;
#pragma unroll
                for (int bj = 0; bj < 2; ++bj) { const f32x4 v0 = acc[ai][bj][m][0], v1 = acc[ai][bj][m][1];
                    u32x4 w; w.x = cvt_pk_bf16(v0[0], v0[1]); w.y = cvt_pk_bf16(v0[2], v0[3]); w.z = cvt_pk_bf16(v1[0], v1[1]); w.w = cvt_pk_bf16(v1[2], v1[3]);
                    *(u32x4*)(rowp + bj * 128) = w; } }
    }
};
struct OSched {
    int G, c, nctx; const char* A; const char* B;
    __device__ __forceinline__ bool next(int i, pg8::Unit& u) const {
        const int L = i * G + c;
        if (L < 256) { int pm, pn; pg8::tile_decode(L, 32, 8, pm, pn); pm = ufl(pm); pn = ufl(pn); u.kind = 0; u.nt = 32; u.pm = pm; u.pn = pn; u.a = A + (size_t)pm * MiB; u.b = B + (size_t)pn * MiB; return true; }
        const int s = L - 256; if (s >= nctx) return false;
        const int ch = s & 3, pn = (s >> 2) & 7, pm = 32 + (s >> 5);
        u.kind = 1 + ch; u.nt = 8; u.pm = pm; u.pn = pn; u.a = A + (size_t)pm * MiB + ch * 1024; u.b = B + (size_t)pn * MiB + ch * 1024; return true;
    }
};
struct ResEpi {
    static constexpr bool HAS_MID = false; static constexpr int MID_T = 0;
    bf16_t* out; const void* xin; int in_bf; float* cs_out; const float* gate; int fuse; float* fout; const float* fg; unsigned char* ctl; LAS float* PL;
    __device__ __forceinline__ void operator()(f32x4 (&acc)[2][2][4][2], const pg8::Unit& u, int wr, int wc, int fr, int fq) const {
        if (fuse && u.kind == 0) { asm volatile("" : "+v"(fr), "+v"(fq)); const int pm = u.pm, pn = u.pn; const size_t o = (size_t)pm * 256 * DM + pn * 256;
            pg8::epi_res_final(acc, (const bf16_t*)xin + o, gate + (size_t)(pm >> 3) * 6144 + pn * 256, fout + o, fg + pn * 256, (float*)(ctl + 65536) + (size_t)pm * 256 * 8, (unsigned*)ctl + 4096 + 64 * pm, pn, PL, wr, wc, fr, fq); }
        else (*this)((pg8::AccRef)acc, u, wr, wc, fr, fq);
    }
    bf16_t* out_;
    __device__ __forceinline__ void operator()(pg8::AccRef acc, const pg8::Unit& u, int wr, int wc, int fr, int fq) const {
        asm volatile("" : "+v"(fr), "+v"(fq));
        const int pm = u.pm, pn = u.pn;
        if (u.kind == 0) { const size_t o = (size_t)pm * 256 * DM + pn * 256; const float* gt = gate + (size_t)(pm >> 3) * 6144 + pn * 256;
            if (in_bf) pg8::epi_res<true>(acc, out + o, (const bf16_t*)xin + o, gt, wr, wc, fr, fq); else pg8::epi_res<false>(acc, out + o, (const float*)xin + o, gt, wr, wc, fr, fq); }
        else { bf16_t* O = (bf16_t*)cs_out + (size_t)(u.kind - 1) * MC * DM + (size_t)(pm - 32) * 256 * DM + pn * 256; const float* gt = gate + (size_t)4 * 6144 + pn * 256;
#pragma unroll
            for (int bj = 0; bj < 2; ++bj) { const f32x4 g0 = *(const f32x4*)(gt + bj * 128 + wc * 32 + 8 * fq), g1 = *(const f32x4*)(gt + bj * 128 + wc * 32 + 8 * fq + 4);
#pragma unroll
                for (int ai = 0; ai < 2; ++ai)
#pragma unroll
                    for (int m = 0; m < 4; ++m) { const f32x4 v0 = g0 * acc[ai][bj][m][0], v1 = g1 * acc[ai][bj][m][1];
                        u32x4 w; w.x = cvt_pk_bf16(v0[0], v0[1]); w.y = cvt_pk_bf16(v0[2], v0[3]); w.z = cvt_pk_bf16(v1[0], v1[1]); w.w = cvt_pk_bf16(v1[2], v1[3]);
                        *(u32x4*)(O + (size_t)(ai * 128 + wr * 64 + m * 16 + fr) * DM + bj * 128 + wc * 32 + 8 * fq) = w; } }
        }
    }
};

namespace att {
constexpr int D = 128, NW = 8, QBLK = 32, KVBLK = 64;
constexpr float SCALE = 0.088388347648318440f;
constexpr float THR = 8.f;
constexpr int LDQ = 1536, LDK = 512, LDZ = 1536, LDO = 2048;
constexpr size_t SHM_V = KVBLK * D * 2, SHM_K = KVBLK * D * 2, SHM_ATTN = 2 * SHM_V + 2 * SHM_K + NW * 64 * 4;
#define KSWZ(row, colB) ((row) * 256 + ((colB) ^ (((row) & 7) << 4)))
#define SBAR() __builtin_amdgcn_sched_barrier(0)
__device__ __forceinline__ int crow(int r, int hi) { return (r & 3) + 8 * (r >> 2) + 4 * hi; }
__device__ __forceinline__ unsigned cvtpk(float lo, float hi) { unsigned r; asm volatile("v_cvt_pk_bf16_f32 %0, %1, %2" : "=v"(r) : "v"(lo), "v"(hi)); return r; }
__device__ __forceinline__ void partialSM(f32x16& p0, f32x16& p1, float& m_reg, float& mn, float& alpha) {
  constexpr float C = SCALE * 1.4426950408889634f;
  float pmax = p0[0]; for (int r = 1; r < 16; ++r) pmax = fmaxf(pmax, p0[r]); for (int r = 0; r < 16; ++r) pmax = fmaxf(pmax, p1[r]);
  { auto rr = __builtin_amdgcn_permlane32_swap(__float_as_uint(pmax), __float_as_uint(pmax), false, false);
    pmax = fmaxf(__uint_as_float(rr[0]), __uint_as_float(rr[1])); }
  if (__builtin_expect(__all(pmax - m_reg <= THR / SCALE), 1)) { mn = m_reg; alpha = 1.f; }
  else { mn = fmaxf(m_reg, pmax); alpha = __builtin_amdgcn_exp2f((m_reg - mn) * C); m_reg = mn; }
  float mnC = -mn * C;
  for (int r = 0; r < 16; ++r) p0[r] = fmaf(p0[r], C, mnC); for (int r = 0; r < 16; ++r) p1[r] = fmaf(p1[r], C, mnC);
  for (int r = 0; r < 16; ++r) p0[r] = __builtin_amdgcn_exp2f(p0[r]);
}
__device__ __forceinline__ void finishSM(f32x16& p0, f32x16& p1, float alpha, float& l_reg, bf16x8& pa0, bf16x8& pa1, bf16x8& pa2, bf16x8& pa3) {
  for (int r = 0; r < 16; ++r) p1[r] = __builtin_amdgcn_exp2f(p1[r]);
  float ps = 0; for (int r = 0; r < 16; ++r) ps += p0[r]; for (int r = 0; r < 16; ++r) ps += p1[r];
  { auto rr = __builtin_amdgcn_permlane32_swap(__float_as_uint(ps), __float_as_uint(ps), false, false);
    ps = __uint_as_float(rr[0]) + __uint_as_float(rr[1]); }
  l_reg = l_reg * alpha + ps;
#define PK4(P, BASE, OUT) do { unsigned a0 = cvtpk(P[BASE + 0], P[BASE + 1]), a1 = cvtpk(P[BASE + 2], P[BASE + 3]);   \
    unsigned b0 = cvtpk(P[BASE + 4], P[BASE + 5]), b1 = cvtpk(P[BASE + 6], P[BASE + 7]);                              \
    auto r0 = __builtin_amdgcn_permlane32_swap(a0, b0, false, false); auto r1 = __builtin_amdgcn_permlane32_swap(a1, b1, false, false); \
    u32x4 w = {r0[0], r1[0], r0[1], r1[1]}; OUT = *reinterpret_cast<bf16x8*>(&w); } while (0)
  PK4(p0, 0, pa0); PK4(p0, 8, pa1); PK4(p1, 0, pa2); PK4(p1, 8, pa3);
#undef PK4
}
__device__ __forceinline__ void qkt(f32x16& p0, f32x16& p1, const bf16_t* Ks, const bf16x8* qr, int r32, int hi) {
  p0 = f32x16{}; p1 = f32x16{};
  for (int d0 = 0; d0 < 8; ++d0) { int cb = (d0 * 16 + hi * 8) * 2;
    bf16x8 b0 = *reinterpret_cast<const bf16x8*>((const char*)Ks + KSWZ(r32, cb));
    bf16x8 b1 = *reinterpret_cast<const bf16x8*>((const char*)Ks + KSWZ(32 + r32, cb));
    p0 = __builtin_amdgcn_mfma_f32_32x32x16_bf16(b0, qr[d0], p0, 0, 0, 0);
    p1 = __builtin_amdgcn_mfma_f32_32x32x16_bf16(b1, qr[d0], p1, 0, 0, 0); }
}
__device__ __forceinline__ int v_st(int k, int c) { const int kk = (k & ~0xC) | ((k & 4) << 1) | ((k & 8) >> 1); return ((kk >> 3) * 4 + (c >> 5)) * 512 + ((kk & 7) * 32 + (c & 31)) * 2; }
__device__ __forceinline__ int v_rd_base(int lane) { return ((lane & 3) << 3) | (((lane >> 2) & 3) << 6) | (((lane >> 4) & 1) << 5) | (((lane >> 5) & 1) << 8); }
constexpr int v_rd_off(int d0, int ks, int half) { return d0 * 512 + ks * 4096 + half * 2048; }
template <int OFF> __device__ __forceinline__ s16x4 tr_read(int vb) {
  s16x4 r; asm volatile("ds_read_b64_tr_b16 %0, %1 offset:%2" : "=&v"(r) : "v"(vb), "i"(OFF) : "memory"); return r;
}
template <int D0> __device__ __forceinline__ void pv_one(f32x16& od, int vb, bf16x8 pa0, bf16x8 pa1, bf16x8 pa2, bf16x8 pa3) {
  const s16x4 l0 = tr_read<v_rd_off(D0, 0, 0)>(vb), h0 = tr_read<v_rd_off(D0, 0, 1)>(vb), l1 = tr_read<v_rd_off(D0, 1, 0)>(vb), h1 = tr_read<v_rd_off(D0, 1, 1)>(vb);
  const s16x4 l2 = tr_read<v_rd_off(D0, 2, 0)>(vb), h2 = tr_read<v_rd_off(D0, 2, 1)>(vb), l3 = tr_read<v_rd_off(D0, 3, 0)>(vb), h3 = tr_read<v_rd_off(D0, 3, 1)>(vb);
  asm volatile("s_waitcnt lgkmcnt(0)" ::: "memory"); SBAR();
#define PK(L, H) (bf16x8){L[0], L[1], L[2], L[3], H[0], H[1], H[2], H[3]}
  od = __builtin_amdgcn_mfma_f32_32x32x16_bf16(pa0, PK(l0, h0), od, 0, 0, 0);
  od = __builtin_amdgcn_mfma_f32_32x32x16_bf16(pa1, PK(l1, h1), od, 0, 0, 0);
  od = __builtin_amdgcn_mfma_f32_32x32x16_bf16(pa2, PK(l2, h2), od, 0, 0, 0);
  od = __builtin_amdgcn_mfma_f32_32x32x16_bf16(pa3, PK(l3, h3), od, 0, 0, 0);
#undef PK
}
__device__ __forceinline__ void pv_d0(f32x16* o, int vb, bf16x8 pa0, bf16x8 pa1, bf16x8 pa2, bf16x8 pa3) {
  pv_one<0>(o[0], vb, pa0, pa1, pa2, pa3); pv_one<1>(o[1], vb, pa0, pa1, pa2, pa3); pv_one<2>(o[2], vb, pa0, pa1, pa2, pa3); pv_one<3>(o[3], vb, pa0, pa1, pa2, pa3);
}
__device__ __forceinline__ void attn_dense_body(const bf16_t* __restrict__ Qb, const bf16_t* __restrict__ Kh, const bf16_t* __restrict__ Vh,
                                                const bf16_t* __restrict__ ZAb, bf16_t* __restrict__ AAb, int seq, char* lds) {
  int tid = threadIdx.x; asm volatile("" : "+v"(tid));
  const int wid = tid >> 6, lane = tid & 63, r32 = lane & 31, hi = lane >> 5;
  bf16_t* V_lds = (bf16_t*)lds; bf16_t* K_lds = (bf16_t*)(lds + 2 * SHM_V);
  float* ws = (float*)(lds + 2 * SHM_V + 2 * SHM_K) + wid * 64; float* li_l = ws; float* al_l = ws + 32;
  float m_reg = -1e30f, l_reg = 0; f32x16 o[4] = {}; bf16x8 qr[8];
  const bf16_t* Qw = Qb + (long)(wid * QBLK + r32) * LDQ + hi * 8;
#pragma unroll
  for (int d0 = 0; d0 < 8; ++d0) qr[d0] = *reinterpret_cast<const bf16x8*>(Qw + d0 * 16);
  const int sr = tid >> 4, sc = (tid & 15) * 8, vst0 = v_st(sr, sc), vst1 = v_st(32 + sr, sc);
  const int vb0 = (int)(uintptr_t)V_lds + v_rd_base(lane);
  struct { bf16x8 vs0, vs1, ks0, ks1; } sr_[2];
#define SLOAD(i, k0) do { sr_[i].vs0 = *reinterpret_cast<const bf16x8*>(&Vh[(long)((k0) + sr) * LDK + sc]); sr_[i].vs1 = *reinterpret_cast<const bf16x8*>(&Vh[(long)((k0) + 32 + sr) * LDK + sc]); \
    sr_[i].ks0 = *reinterpret_cast<const bf16x8*>(&Kh[(long)((k0) + sr) * LDK + sc]); sr_[i].ks1 = *reinterpret_cast<const bf16x8*>(&Kh[(long)((k0) + 32 + sr) * LDK + sc]); } while (0)
#define SWRITE(b, i) do { *(bf16x8*)((char*)V_lds + (b) * SHM_V + vst0) = sr_[i].vs0;          \
    *(bf16x8*)((char*)V_lds + (b) * SHM_V + vst1) = sr_[i].vs1; int kc = sc * 2;               \
    *(bf16x8*)((char*)K_lds + (b) * SHM_K + KSWZ(sr, kc)) = sr_[i].ks0;                       \
    *(bf16x8*)((char*)K_lds + (b) * SHM_K + KSWZ(32 + sr, kc)) = sr_[i].ks1; } while (0)
#define SWAIT() asm volatile("s_waitcnt vmcnt(4)" ::: "memory")
#define RESC(a) do { if (__any((a) < 1.f)) { if (hi == 0) al_l[r32] = (a); asm volatile("s_waitcnt lgkmcnt(0)" ::: "memory"); \
    for (int d = 0; d < 4; ++d) for (int r = 0; r < 16; ++r) o[d][r] *= al_l[crow(r, hi)]; } } while (0)
  f32x16 pA0, pA1, pB0, pB1; float mnA, mnB, alA, alB; bf16x8 pa0, pa1, pa2, pa3; const int NT = seq / KVBLK;
  constexpr int SE = 0, SO = 1;
  SLOAD(SE, 0); asm volatile("s_waitcnt vmcnt(0)" ::: "memory"); SWRITE(0, SE); __syncthreads();
  qkt(pA0, pA1, K_lds, qr, r32, hi); partialSM(pA0, pA1, m_reg, mnA, alA);
  SLOAD(SO, KVBLK); if (2 < NT) SLOAD(SE, 2 * KVBLK);
  SWAIT(); SWRITE(1, SO); __syncthreads();
  for (int j = 1; j + 1 < NT; j += 2) {
    SBAR(); qkt(pB0, pB1, (bf16_t*)((char*)K_lds + SHM_K), qr, r32, hi);
    finishSM(pA0, pA1, alA, l_reg, pa0, pa1, pa2, pa3); SBAR();
    SLOAD(SO, (j + 2) * KVBLK); SBAR();
    pv_d0(o, vb0, pa0, pa1, pa2, pa3); partialSM(pB0, pB1, m_reg, mnB, alB);
    __syncthreads(); SWAIT(); SWRITE(0, SE);
    RESC(alB); __syncthreads();
    SBAR(); qkt(pA0, pA1, K_lds, qr, r32, hi);
    finishSM(pB0, pB1, alB, l_reg, pa0, pa1, pa2, pa3); SBAR();
    if (j + 3 < NT) SLOAD(SE, (j + 3) * KVBLK); SBAR();
    pv_d0(o, vb0 + (int)SHM_V, pa0, pa1, pa2, pa3); partialSM(pA0, pA1, m_reg, mnA, alA);
    __syncthreads(); SWAIT(); SWRITE(1, SO);
    RESC(alA); __syncthreads();
  }
  SBAR(); qkt(pB0, pB1, (bf16_t*)((char*)K_lds + SHM_K), qr, r32, hi);
  finishSM(pA0, pA1, alA, l_reg, pa0, pa1, pa2, pa3); SBAR();
  pv_d0(o, vb0, pa0, pa1, pa2, pa3); partialSM(pB0, pB1, m_reg, mnB, alB);
  __syncthreads(); RESC(alB);
  finishSM(pB0, pB1, alB, l_reg, pa0, pa1, pa2, pa3); SBAR();
  pv_d0(o, vb0 + (int)SHM_V, pa0, pa1, pa2, pa3);
  if (hi == 0) li_l[r32] = l_reg; asm volatile("s_waitcnt lgkmcnt(0)" ::: "memory");
  float rli[16];
#pragma unroll
  for (int r = 0; r < 16; ++r) rli[r] = __builtin_amdgcn_rcpf(li_l[crow(r, hi)]);
  __syncthreads();
  { char* stg = lds + wid * 8192;
#pragma unroll
    for (int r = 0; r < 16; ++r) { const int orow = crow(r, hi);
#pragma unroll
      for (int d0 = 0; d0 < 4; ++d0) *(bf16_t*)(stg + orow * 256 + (d0 * 32 + r32) * 2) = (bf16_t)(cvtpk(o[d0][r] * rli[r], 0.f) & 0xffffu); }
    asm volatile("s_waitcnt lgkmcnt(0)" ::: "memory");
    int lane_ = lane; asm volatile("" : "+v"(lane_));
    const int rr = lane_ >> 4, ch = lane_ & 15;
#pragma unroll
    for (int i = 0; i < 8; ++i) { const int row = i * 4 + rr; const u32x4 ov = *(const u32x4*)(stg + row * 256 + ch * 16);
      const long gi = (long)(wid * QBLK + row) * LDO + ch * 8; const u32x4 z = *(const u32x4*)(ZAb + (long)(wid * QBLK + row) * LDZ + ch * 8); u32x4 w;
      w.x = cvtpk(bf_lo(ov.x) * bf_lo(z.x), bf_hi(ov.x) * bf_hi(z.x)); w.y = cvtpk(bf_lo(ov.y) * bf_lo(z.y), bf_hi(ov.y) * bf_hi(z.y));
      w.z = cvtpk(bf_lo(ov.z) * bf_lo(z.z), bf_hi(ov.z) * bf_hi(z.z)); w.w = cvtpk(bf_lo(ov.w) * bf_lo(z.w), bf_hi(ov.w) * bf_hi(z.w));
      *(u32x4*)(AAb + gi) = w; } }
#undef SLOAD
#undef SWRITE
#undef SWAIT
#undef RESC
}
#undef KSWZ
#undef SBAR
}


#define XB_TMO      128
#define XB_XCNT(j)  (256  + 64 * (j))
#define XB_XSUB(j)  (1280 + 64 * (j))
#define XB_XGEN(j)  (2304 + 64 * (j))
#define XB_TOP      3328
#define XB_TOPGEN   3392
#define XCD_BAR_WORDS 3456
#define XB_SPIN_CAP (1u << 18)
__device__ __forceinline__ unsigned xb_ld(unsigned* p)              { return __hip_atomic_load(p, __ATOMIC_RELAXED, __HIP_MEMORY_SCOPE_AGENT); }
__device__ __forceinline__ unsigned xb_add(unsigned* p, unsigned v) { return __hip_atomic_fetch_add(p, v, __ATOMIC_RELAXED, __HIP_MEMORY_SCOPE_AGENT); }
__device__ __forceinline__ unsigned xb_xcc_id() { return (unsigned)__builtin_amdgcn_s_getreg((3 << 11) | 20) & 0xFu; }
#define XB_SPIN(cond, bar) do { unsigned _sp = 0; while (cond) { __builtin_amdgcn_s_sleep(1); \
    if ((++_sp & 255u) == 0u) { if (xb_ld(&(bar)[XB_TMO])) break; if (_sp > XB_SPIN_CAP) { atomicAdd(&(bar)[XB_TMO], 1u); break; } } } } while (0)
struct XcdBarrier { unsigned* bar; unsigned x; volatile LAS unsigned* st; };
__device__ __forceinline__ XcdBarrier xcd_barrier_post(unsigned* bar, volatile LAS unsigned* st) {
    XcdBarrier b; b.bar = bar; b.x = xb_xcc_id(); b.st = st;
    if (threadIdx.x == 0) (void)xb_add(&bar[XB_XCNT(b.x)], 1u);
    return b;
}
__device__ __forceinline__ void xcd_barrier_complete(unsigned* bar, unsigned x, unsigned& nloc, unsigned& nx) {
    const unsigned G = gridDim.x * gridDim.y * gridDim.z;
    unsigned sum, cnt, mine, sp = 0u;
    for (;;) {
        sum = 0u; cnt = 0u; mine = 0u;
#pragma unroll
        for (unsigned j = 0; j < 16; ++j) { const unsigned c = xb_ld(&bar[XB_XCNT(j)]); sum += c; cnt += (c > 0u) ? 1u : 0u; mine = (j == x) ? c : mine; }
        if (sum == G) break;
        __builtin_amdgcn_s_sleep(1);
        if ((++sp & 255u) == 0u) { if (xb_ld(&bar[XB_TMO])) break; if (sp > XB_SPIN_CAP) { atomicAdd(&bar[XB_TMO], 1u); break; } }
    }
    nloc = mine > 0u ? mine : 1u; nx = cnt > 0u ? cnt : 1u;
}
__device__ __forceinline__ void xcd_barrier(const XcdBarrier& b) {
    asm volatile("s_waitcnt vmcnt(0)" ::: "memory");
    __syncthreads();
    if (threadIdx.x == 0) {
        unsigned* bar = b.bar;
        __builtin_amdgcn_s_waitcnt(0);
        unsigned nloc = b.st[0], nx = b.st[1];
        if (nloc == 0u) { xcd_barrier_complete(bar, b.x, nloc, nx); b.st[0] = nloc; b.st[1] = nx; }
        const unsigned old = xb_add(&bar[XB_XSUB(b.x)], 1u);
        const unsigned gen = old / nloc;
        if (old + 1u == (gen + 1u) * nloc) {
            __builtin_amdgcn_fence(__ATOMIC_RELEASE, "agent");
            asm volatile("s_waitcnt vmcnt(0)" ::: "memory");
            const unsigned og = xb_add(&bar[XB_TOP], 1u);
            const unsigned tg = og / nx;
            if (og + 1u == (tg + 1u) * nx) xb_add(&bar[XB_TOPGEN], 1u);
            else XB_SPIN(xb_ld(&bar[XB_TOPGEN]) == tg, bar);
            __builtin_amdgcn_fence(__ATOMIC_ACQUIRE, "agent");
            xb_add(&bar[XB_XGEN(b.x)], 1u);
            asm volatile("s_waitcnt vmcnt(0)" ::: "memory");
        } else {
            XB_SPIN(xb_ld(&bar[XB_XGEN(b.x)]) == gen, bar);
            __builtin_amdgcn_fence(__ATOMIC_ACQUIRE, "agent");
            asm volatile("s_waitcnt vmcnt(0)" ::: "memory");
        }
    }
    __syncthreads();
}

struct Args { const float* in[14]; float* out; unsigned char* ws; int ph_lo, ph_hi; };

__device__ __forceinline__ int winT_row(int n) {
    if (n < 2048) { const int hb = n & ~127, d = n & 127, axis = d >> 6, nn = (d >> 5) & 1, f = d & 31; const int wc = axis * 2 + (f >> 4), fq = (f >> 2) & 3, e = f & 3; return hb + wc * 32 + 8 * fq + 4 * nn + e; }
    if (n < 4096) return n;
    return n + 512;
}
template <bool PERMW>
__device__ __forceinline__ void p0_tr_load(const float* W, int N, int kb, int nb, int lane, f32x4 (&v)[8]) {
    const float* src = W + (size_t)(64 * kb + 8 * (lane & 7)) * N + 32 * nb + 4 * (lane >> 3);
#pragma unroll
    for (int e = 0; e < 8; ++e) v[e] = __builtin_nontemporal_load((const f32x4*)(src + (size_t)e * N));
}
template <bool PERMW>
__device__ __forceinline__ void p0_tr_store(bf16_t* WT, int K  , int kb, int nb, int lane, const f32x4 (&v)[8]) {
    const int kq = lane & 7, ng = lane >> 3;
#pragma unroll
    for (int j = 0; j < 4; ++j) { const int n = 32 * nb + 4 * ng + j, row = PERMW ? winT_row(n) : n;
        u32x4 o; o.x = cvt_pk_bf16(v[0][j], v[1][j]); o.y = cvt_pk_bf16(v[2][j], v[3][j]); o.z = cvt_pk_bf16(v[4][j], v[5][j]); o.w = cvt_pk_bf16(v[6][j], v[7][j]);
        *(u32x4*)(WT + (size_t)row * K + 64 * kb + 8 * kq) = o; }
}
struct TrItem { const float* W; bf16_t* WT; int K, N, kb, nb, perm; };
constexpr int TI_IN = 32 * 272, TI_PA = 24 * 64, TI_PB = 8 * 64, TI_O = 32 * 64, TI_L = TI_IN + TI_PA + TI_PB + TI_O;
__device__ __forceinline__ TrItem tr_decode(int it, const float* w_in, const float* w_pa, const float* w_pb, const float* w_out, unsigned char* ws) {
    TrItem t; const int l = it / TI_L; int r = it % TI_L;
    if (r < TI_IN) { const int kb = r / 272, nb0 = r % 272; t.W = w_in + (size_t)l * DM * INW; t.WT = (bf16_t*)(ws + WS_WIN + (size_t)l * 38 * MiB); t.K = DM; t.N = INW; t.kb = kb; t.nb = nb0 < 128 ? nb0 : nb0 + 16; t.perm = 1; return t; }
    r -= TI_IN;
    if (r < TI_PA) { t.W = w_pa + (size_t)l * 1536 * DM; t.WT = (bf16_t*)(ws + WS_WCAT + (size_t)l * 8 * MiB) + 512; t.K = DM; t.N = DM; t.kb = r / 64; t.nb = r % 64; t.perm = 0; return t; }
    r -= TI_PA;
    if (r < TI_PB) { t.W = w_pb + (size_t)l * 512 * DM; t.WT = (bf16_t*)(ws + WS_WCAT + (size_t)l * 8 * MiB); t.K = DM; t.N = DM; t.kb = r / 64; t.nb = r % 64; t.perm = 0; return t; }
    r -= TI_PB;
    t.W = w_out + (size_t)l * DM * DM; t.WT = (bf16_t*)(ws + WS_WO + (size_t)l * 8 * MiB); t.K = DM; t.N = DM; t.kb = r / 64; t.nb = r % 64; t.perm = 0; return t;
}

__global__ void __launch_bounds__(512, 2) mk_fwd(Args args) {
    extern __shared__ __attribute__((aligned(16))) unsigned char lds_raw[];
    LAS unsigned char* lds = (LAS unsigned char*)lds_raw;
    const int tid = threadIdx.x, lane = tid & 63, wave = __builtin_amdgcn_readfirstlane(tid >> 6);
    const int G = gridDim.x, cb = blockIdx.x;
    const int vcu = (G % 8 == 0) ? (cb % 8) * (G / 8) + cb / 8 : cb;
    unsigned char* ws = args.ws;
    const float *x = args.in[0], *cvec = args.in[1], *ctx = args.in[2], *c_ctx = args.in[3], *w_ada = args.in[4], *b_ada = args.in[5], *norm_g = args.in[6], *w_in = args.in[7],
                *q_norm_g = args.in[8], *k_norm_g = args.in[9], *w_pa = args.in[10], *w_pb = args.in[11], *w_out = args.in[12], *final_g = args.in[13];
    float* out = args.out;
    float* MOD = (float*)(ws + WS_MOD); float* ROPE = (float*)(ws + WS_TAB); bf16_t* DM256 = (bf16_t*)(ws + WS_TAB + 65536); bf16_t* DM2K = (bf16_t*)(ws + WS_DM);
    bf16_t *Hb = (bf16_t*)(ws + WS_H), *Qb = (bf16_t*)(ws + WS_Q), *Kb = (bf16_t*)(ws + WS_K), *Vb = (bf16_t*)(ws + WS_V), *ZA = (bf16_t*)(ws + WS_ZA), *ZB = (bf16_t*)(ws + WS_ZB),
           *GA = (bf16_t*)(ws + WS_GA), *GB = (bf16_t*)(ws + WS_GB), *UT = (bf16_t*)(ws + WS_UT), *UTC = (bf16_t*)(ws + WS_UTC), *ACAT = (bf16_t*)(ws + WS_ACAT), *MM = (bf16_t*)(ws + WS_MM);
    bf16_t* XS = (bf16_t*)(ws + WS_XS);
    const int lo = args.ph_lo, hi = args.ph_hi;
#ifndef PHMASK
#define PHMASK 0xffffu
#endif
#define PHON(k) (((PHMASK) >> ((k) > 5 && (k) < 11 ? (k) - 5 : (k))) & 1u)
#define IN(k) (PHON(k) && lo <= (k) && (k) < hi)
#if MK_XCD_BAR
    volatile LAS unsigned* MISC = (volatile LAS unsigned*)(lds + LDS_MISC);
    if (tid < 2) MISC[tid] = 0u;
    __syncthreads();
    XcdBarrier xbar; xbar.bar = (unsigned*)ws; xbar.x = 0; xbar.st = MISC;
    if (hi - lo > 1 && cb == 0) { for (int i = tid; i < 12288; i += 512) ((unsigned*)ws)[i] = 0u; }
#define SEAM(k) do { if (IN(k) && IN((k) + 1)) { if ((k) == 0) { cg::this_grid().sync(); xbar = xcd_barrier_post((unsigned*)ws, MISC); } else xcd_barrier(xbar); } } while (0)
#else
#define SEAM(k) do { if (IN(k) && IN((k) + 1)) { cg::this_grid().sync(); } } while (0)
#endif
    const int gw = vcu * 8 + wave, NGW = G * 8;

    for (int rep = 0; rep < NREP(0); ++rep)
    if (IN(0)) {
        const int tb0 = G == 256 ? 192 : 0, tbn = G - tb0;
        if (cb >= tb0) {
            LAS float* ctab = (LAS float*)lds;
            for (int i = tid; i < 2048; i += 512) ctab[i] = cospif((float)i * (1.f / 1024.f)) * 0.022097086912079608f;
            __syncthreads();
            for (int idx8 = (cb - tb0) * 512 + tid; idx8 < 2048 * 512; idx8 += tbn * 512) { const int n = idx8 >> 9, j0 = (idx8 & 511) * 8; float v[8];
#pragma unroll
                for (int e = 0; e < 8; ++e) { const int j = j0 + e; v[e] = j < 2048 ? ctab[(n * j) & 2047] : -ctab[(n * (j - 2048) - 512) & 2047]; }
                u32x4 o; o.x = cvt_pk_bf16(v[0], v[1]); o.y = cvt_pk_bf16(v[2], v[3]); o.z = cvt_pk_bf16(v[4], v[5]); o.w = cvt_pk_bf16(v[6], v[7]);
                *(u32x4*)(DM2K + (size_t)n * 4096 + j0) = o; }
            for (int idx8 = (cb - tb0) * 512 + tid; idx8 < 256 * 64; idx8 += tbn * 512) { const int n = idx8 >> 6, j0 = (idx8 & 63) * 8; float v[8];
#pragma unroll
                for (int e = 0; e < 8; ++e) { const int j = j0 + e; v[e] = 2.8284271247461903f * (j < 256 ? ctab[((n * j) & 255) * 8] : -ctab[((((n * (j - 256)) & 255) * 8) - 512) & 2047]); }
                u32x4 o; o.x = cvt_pk_bf16(v[0], v[1]); o.y = cvt_pk_bf16(v[2], v[3]); o.z = cvt_pk_bf16(v[4], v[5]); o.w = cvt_pk_bf16(v[6], v[7]);
                *(u32x4*)(DM256 + (size_t)n * 512 + j0) = o; }
            for (int idx = (cb - tb0) * 512 + tid; idx < 64 * 32; idx += tbn * 512) { const int pos = idx >> 5, f = idx & 31; const float inv = exp2f(-(float)f * (13.287712379549449f / 32.f)); const float ang = (float)pos * inv;
                ROPE[idx * 2] = cosf(ang); ROPE[idx * 2 + 1] = sinf(ang); }
            for (int idx8 = (cb - tb0) * 512 + tid; idx8 < 256 * 16; idx8 += tbn * 512) { const int jp = idx8 >> 4, c0 = (idx8 & 15) * 8, cp = jp & 127; float v[8];
#pragma unroll
                for (int e = 0; e < 8; ++e) { const float ph = (float)(((c0 + e) * cp) & 127) * (1.f / 64.f); v[e] = (jp < 128 ? cospif(ph) : sinpif(ph)) * 0.08838834764831845f; }
                u32x4 o; o.x = cvt_pk_bf16(v[0], v[1]); o.y = cvt_pk_bf16(v[2], v[3]); o.z = cvt_pk_bf16(v[4], v[5]); o.w = cvt_pk_bf16(v[6], v[7]);
                *(u32x4*)((bf16_t*)(ws + WS_TT) + jp * 128 + c0) = o; }
            __syncthreads();
        }
        {
            LAS float* sc = (LAS float*)lds;
            LAS float* part = (LAS float*)(lds + 40960);
            for (int idx = tid; idx < 5 * 2048; idx += 512) { const int r = idx >> 11, k = idx & 2047; const float v = r < 4 ? cvec[r * 2048 + k] : c_ctx[k]; sc[idx] = v * sigmoidf_(v); }
            __syncthreads();
            for (int item = cb; item < 192; item += G) {
                const int l = item / 96, cc = item % 96, cg4 = lane & 15, kp = lane >> 4;
                const float* wp = w_ada + ((size_t)l * 2048 + wave * 256 + kp) * 6144 + cc * 64 + cg4 * 4;
                f32x4 a0 = {0.f, 0.f, 0.f, 0.f}, a1 = a0, a2 = a0, a3 = a0, a4 = a0;
#pragma unroll 8
                for (int i = 0; i < 64; ++i) { const f32x4 w = *(const f32x4*)(wp + (size_t)i * 4 * 6144); const int k = wave * 256 + 4 * i + kp;
                    a0 += w * sc[k]; a1 += w * sc[2048 + k]; a2 += w * sc[4096 + k]; a3 += w * sc[6144 + k]; a4 += w * sc[8192 + k]; }
#pragma unroll
                for (int e = 0; e < 4; ++e) { a0[e] += __shfl_xor(a0[e], 16); a0[e] += __shfl_xor(a0[e], 32); a1[e] += __shfl_xor(a1[e], 16); a1[e] += __shfl_xor(a1[e], 32);
                    a2[e] += __shfl_xor(a2[e], 16); a2[e] += __shfl_xor(a2[e], 32); a3[e] += __shfl_xor(a3[e], 16); a3[e] += __shfl_xor(a3[e], 32); a4[e] += __shfl_xor(a4[e], 16); a4[e] += __shfl_xor(a4[e], 32); }
                if (kp == 0) { LAS float* pp = part + wave * 320 + cg4 * 4;
                    *(LAS f32x4*)(pp) = a0; *(LAS f32x4*)(pp + 64) = a1; *(LAS f32x4*)(pp + 128) = a2; *(LAS f32x4*)(pp + 192) = a3; *(LAS f32x4*)(pp + 256) = a4; }
                __syncthreads();
                if (tid < 320) { const int r = tid >> 6, j = tid & 63; float s = b_ada[l * 6144 + cc * 64 + j];
#pragma unroll
                    for (int w = 0; w < 8; ++w) s += part[w * 320 + r * 64 + j];
                    MOD[((size_t)l * 5 + r) * 6144 + cc * 64 + j] = s; }
                __syncthreads();
            }
            __syncthreads();
        }
        {
            for (int it = gw; it < 2 * TI_L; it += 2 * NGW) {
                const TrItem t0 = tr_decode(it, w_in, w_pa, w_pb, w_out, ws); const bool two = it + NGW < 2 * TI_L;
                const TrItem t1 = tr_decode(two ? it + NGW : it, w_in, w_pa, w_pb, w_out, ws);
                f32x4 v0[8], v1[8];
                p0_tr_load<false>(t0.W, t0.N, t0.kb, t0.nb, lane, v0);
                if (two) p0_tr_load<false>(t1.W, t1.N, t1.kb, t1.nb, lane, v1);
                if (t0.perm) p0_tr_store<true>(t0.WT, t0.K, t0.kb, t0.nb, lane, v0); else p0_tr_store<false>(t0.WT, t0.K, t0.kb, t0.nb, lane, v0);
                if (two) { if (t1.perm) p0_tr_store<true>(t1.WT, t1.K, t1.kb, t1.nb, lane, v1); else p0_tr_store<false>(t1.WT, t1.K, t1.kb, t1.nb, lane, v1); }
            }
            __syncthreads();
        }
        {
            bf16_t* WUB = (bf16_t*)(ws + WS_WUB);
            for (int idx8 = cb * 512 + tid; idx8 < 2 * 4 * 2048 * 16; idx8 += G * 512) { const int e = idx8 * 8, c0 = e & 127, k = (e >> 7) & 2047, g = (e >> 18) & 3, l2 = e >> 20;
                const float* src = w_in + ((size_t)l2 * DM + k) * INW + 4096 + g * 128 + c0; const f32x4 a = *(const f32x4*)src, b = *(const f32x4*)(src + 4);
                u32x4 o; o.x = cvt_pk_bf16(a[0], a[1]); o.y = cvt_pk_bf16(a[2], a[3]); o.z = cvt_pk_bf16(b[0], b[1]); o.w = cvt_pk_bf16(b[2], b[3]);
                *(u32x4*)(WUB + e) = o; }
        }
    }
    SEAM(0);

    const bool handoff = (G == 256 && hi - lo > 1);
    const bool fuse_final = (G == 256 && hi - lo > 1);
    for (int l = 0; l < 2; ++l) {
        const int P = 1 + 5 * l;
        const float* modl = MOD + (size_t)l * 5 * 6144;
        const int nM = l == 0 ? 36 : 32;
        for (int rep = 0; rep < NREP(P + 0); ++rep)
        if (IN(P)) {
            int lane = tid & 63; asm volatile("" : "+v"(lane));
            const float* xs = x; const float* cs = ctx; const float* PART = (const float*)(ws + WS_PART); const float* gn = norm_g + l * DM;
            const bool foldcu = (l == 0 && G == 256);
            const int r0 = foldcu ? (vcu >= 64 ? (vcu - 64) * 8 + wave : MT) : gw, rstep = foldcu ? 192 * 8 : NGW;
            const bool nbal = (l == 1 && G == 256);
            const int kmax = nbal ? 5 : (r0 < MT ? (MT - r0 + rstep - 1) / rstep : 0);
            for (int k = 0; k < kmax; ++k) {
                int r;
                if (nbal) { if (gw < 1024) { if (k == 4) continue; r = k == 0 ? ML + gw : gw + (k - 1) * 1024; } else r = 3072 + (gw - 1024) + k * 1024; }
                else r = r0 + k * rstep;
                const float* src = r < ML ? xs + (size_t)r * DM : cs + (size_t)(r - ML) * DM;
                const float* mrow = modl + (size_t)(r < ML ? (r >> 11) : 4) * 6144;
                f32x4 v[8]; float ss = 0.f;
#pragma unroll
                for (int j = 0; j < 8; ++j) v[j] = (f32x4){0.f, 0.f, 0.f, 0.f};
                if (!(l == 1 && r < ML)) {
#pragma unroll
                    for (int j = 0; j < 8; ++j) v[j] = *(const f32x4*)(src + j * 256 + lane * 4); }
                else {
#pragma unroll
                    for (int j = 0; j < 8; ++j) { const u32x2 q = *(const u32x2*)(XS + (size_t)r * DM + j * 256 + lane * 4); v[j] = (f32x4){bf_lo(q.x), bf_hi(q.x), bf_lo(q.y), bf_hi(q.y)}; } }
                if (l == 1 && r >= ML) {
                    const bf16_t* pp = (const bf16_t*)PART + (size_t)(r - ML) * DM + lane * 4;
#pragma unroll
                    for (int ch = 0; ch < 4; ++ch)
#pragma unroll
                        for (int j = 0; j < 8; ++j) { const u32x2 q = *(const u32x2*)(pp + (size_t)ch * MC * DM + j * 256); v[j] += (f32x4){bf_lo(q.x), bf_hi(q.x), bf_lo(q.y), bf_hi(q.y)}; } }
#pragma unroll
                for (int j = 0; j < 8; ++j) ss += (v[j][0] * v[j][0] + v[j][1] * v[j][1]) + (v[j][2] * v[j][2] + v[j][3] * v[j][3]);
                const float rstd = __builtin_amdgcn_rsqf(wave_sum(ss) * (1.f / DM) + EPS);
#pragma unroll
                for (int j = 0; j < 8; ++j) { const int col = j * 256 + lane * 4; const f32x4 g = *(const f32x4*)(gn + col), sh = *(const f32x4*)(mrow + col), sl = *(const f32x4*)(mrow + 2048 + col);
                    const f32x4 h = (v[j] * rstd * g) * (sl + 1.f) + sh; u32x2 w; w.x = cvt_pk_bf16(h[0], h[1]); w.y = cvt_pk_bf16(h[2], h[3]);
                    *(u32x2*)(Hb + (size_t)r * DM + col) = w; }
            }
            if (l == 0) {
                __syncthreads();
                FoldSched S; S.G = G; S.c = vcu; S.Tt = (const char*)(ws + WS_TT); S.Wub = (const char*)(ws + WS_WUB);
                FoldEpi E; E.ws = ws; pg8::gemm_phase(lds, 128, S, E);
            }
        }
        SEAM(P);
        for (int rep = 0; rep < NREP(P + 1); ++rep)
        if (IN(P + 1)) {
            G1Sched S; S.Gq = G; S.cq = cb; S.nM = nM; S.nA = nM * 18; S.n1 = 4 * nM; S.n2 = l == 0 ? 0 : 16; S.Lbase = 0;
            S.split = (l == 0 && G == 256) ? 1 : 0;
            { const int tot = S.nA + S.n1 + S.n2 + nM * 16; S.Lend = (l == 0 && G == 256) ? 1280 : tot; }
            S.H = (const char*)Hb; S.W = (const char*)(ws + WS_WIN + (size_t)l * 38 * MiB);
            G1Epi E; E.ws = ws; E.qg = q_norm_g + l * 128; E.kg = k_norm_g + l * 128; E.X = (LAS float*)(lds + LDS_X);
            pg8::gemm_phase(lds, DM, S, E);
        }
        SEAM(P + 1);
        for (int rep = 0; rep < NREP(P + 2); ++rep)
        if (IN(P + 2)) {
            const int nun = l == 0 ? 384 + 48 : 384;
#ifndef NO_ATT
            const int astride = (l == 1 && G == 256) ? 192 : G;
            const bool ctxm1 = (l == 0 && G == 256 && hi - lo > 1);
            const int nk = ctxm1 ? 3 : (nun + astride - 1) / astride + 1;
            for (int k = 0; k < nk; ++k) {
                int a;
                if (ctxm1) a = (k == 0) ? (vcu < 48 ? 384 + vcu : -1) : (vcu + (k - 1) * 256 < 384 ? vcu + (k - 1) * 256 : -1);
                else { a = vcu < astride ? vcu + k * astride : -1; if (a >= nun) a = -1; }
                if (a < 0) continue;
                __syncthreads();
                size_t qo, ko, ao; int seq;
                if (a < 384) { const int bk = a / 24, hq = (a % 24) >> 3, qb = a & 7, b = bk >> 2, kvh = bk & 3, h = kvh * 3 + hq;
                    qo = ((size_t)b * SEQ + qb * 256) * 1536 + h * 128; ao = ((size_t)b * SEQ + qb * 256) * DM + 512 + h * 128; ko = (size_t)b * KEYS * 512 + kvh * 128; seq = KEYS;
                } else { const int a2 = a - 384, b = a2 / 12, h = a2 % 12, kvh = h / 3;
                    qo = ((size_t)ML + b * CTX) * 1536 + h * 128; ao = ((size_t)ML + b * CTX) * DM + 512 + h * 128; ko = ((size_t)b * KEYS + SEQ) * 512 + kvh * 128; seq = CTX; }
                qo = ufl64(qo); ko = ufl64(ko); ao = ufl64(ao); seq = ufl(seq);
                att::attn_dense_body(Qb + qo, Kb + ko, Vb + ko, ZA + qo, ACAT + ao, seq, (char*)lds_raw);
                if (ctxm1 && a >= 384) {
                    asm volatile("s_waitcnt vmcnt(0)" ::: "memory"); __syncthreads();
                    if (tid == 0) { __builtin_amdgcn_fence(__ATOMIC_RELEASE, "agent"); asm volatile("s_waitcnt vmcnt(0)" ::: "memory");
                        (void)__hip_atomic_fetch_add((unsigned*)ws + CW_CTXCNT, 1u, __ATOMIC_RELAXED, __HIP_MEMORY_SCOPE_AGENT); }
                }
            }
#endif
            __syncthreads();
#ifndef NO_FN
            { FnSched S; S.G = G; S.c = vcu; S.cu0 = G >= 256 ? 192 : 0; S.nunits = 64; S.ntn = 8; S.nt = 64; S.A = (const char*)DM2K; S.B = (const char*)UT; S.astep = 2 * MiB; S.bstep = 2 * MiB; S.bbatch = 4 * MiB; S.row_base = 0; S.rows_per_b = SEQ;
              FnEpi E; E.ACAT = ACAT; E.ZB = ZB; pg8::gemm_phase(lds, 4096, S, E); }
            if (l == 0) { FnSched S; S.G = G; S.c = vcu; S.cu0 = G >= 256 ? 176 : 0; S.nunits = 8; S.ntn = 1; S.nt = 8; S.A = (const char*)DM256; S.B = (const char*)UTC; S.astep = 0; S.bstep = MiB / 4; S.bbatch = MiB / 2; S.row_base = ML; S.rows_per_b = CTX;
              FnEpi E; E.ACAT = ACAT; E.ZB = ZB; pg8::gemm_phase(lds, 512, S, E); }
#endif
            if (ctxm1 && vcu >= 176 && vcu < 184) {
                asm volatile("s_waitcnt vmcnt(0)" ::: "memory"); __syncthreads();
                if (tid == 0) { __builtin_amdgcn_fence(__ATOMIC_RELEASE, "agent"); asm volatile("s_waitcnt vmcnt(0)" ::: "memory");
                    (void)__hip_atomic_fetch_add((unsigned*)ws + CW_CTXCNT, 1u, __ATOMIC_RELAXED, __HIP_MEMORY_SCOPE_AGENT); }
            }
            if (l == 0 && G == 256) {
                G1Sched S; S.Gq = 64; S.cq = (vcu >= 160 && vcu < 176) ? vcu - 160 : (vcu >= 184 && vcu < 192) ? 16 + vcu - 184 : (vcu >= 128 && vcu < 160) ? 24 + vcu - 128 : (vcu >= 176 && vcu < 184) ? 56 + vcu - 176 : -1; S.nM = nM; S.nA = nM * 18; S.n1 = 4 * nM; S.n2 = 0; S.Lbase = 1280; S.Lend = S.nA + S.n1 + nM * 16; S.split = 1;
                S.H = (const char*)Hb; S.W = (const char*)(ws + WS_WIN);
                G1Epi E; E.ws = ws; E.qg = q_norm_g; E.kg = k_norm_g; E.X = (LAS float*)(lds + LDS_X);
                pg8::gemm_phase(lds, DM, S, E);
            }
            if (ctxm1 && vcu >= 128 && vcu < 160) {
                if (tid == 0) { unsigned sp = 0;
                    while (__hip_atomic_load((unsigned*)ws + CW_CTXCNT, __ATOMIC_RELAXED, __HIP_MEMORY_SCOPE_AGENT) < 56u) { __builtin_amdgcn_s_sleep(2); if (++sp > (1u << 22)) break; }
                    __builtin_amdgcn_fence(__ATOMIC_ACQUIRE, "agent"); asm volatile("s_waitcnt vmcnt(0)" ::: "memory"); }
                __syncthreads();
                CtxM1Sched S; S.cq = vcu - 128; S.A = (const char*)ACAT; S.B = (const char*)(ws + WS_WCAT);
                M1Epi E; E.MMo = MM; E.GA = GA; E.GB = GB; pg8::gemm_phase(lds, DM, S, E);
            }
        }
        SEAM(P + 2);
        for (int rep = 0; rep < NREP(P + 3); ++rep)
        if (IN(P + 3)) {
            GridSched S; S.G = G; S.c = cb; S.nM = (l == 0 && G == 256 && hi - lo > 1) ? 32 : nM; S.nN = 8; S.nt = 32; S.A = (const char*)ACAT; S.B = (const char*)(ws + WS_WCAT + (size_t)l * 8 * MiB); S.astep = MiB; S.bstep = MiB;
            M1Epi E; E.MMo = MM; E.GA = GA; E.GB = GB; pg8::gemm_phase(lds, DM, S, E);
            if (handoff) {
                int pm_, pn_; pg8::tile_decode(cb, 32, 8, pm_, pn_); pm_ = ufl(pm_);
                asm volatile("s_waitcnt vmcnt(0)" ::: "memory"); __syncthreads();
                if (tid == 0) { __builtin_amdgcn_fence(__ATOMIC_RELEASE, "agent"); asm volatile("s_waitcnt vmcnt(0)" ::: "memory");
                    (void)__hip_atomic_fetch_add((unsigned*)ws + 6144 + 64 * (l * 32 + pm_), 1u, __ATOMIC_RELAXED, __HIP_MEMORY_SCOPE_AGENT); }
            }
        }
        if (!handoff) SEAM(P + 3);
        for (int rep = 0; rep < NREP(P + 4); ++rep)
        if (IN(P + 4)) {
            if (handoff) {
                int pm_, pn_; pg8::tile_decode(cb, 32, 8, pm_, pn_); pm_ = ufl(pm_);
                if (tid == 0) { unsigned sp = 0;
                    while (__hip_atomic_load((unsigned*)ws + 6144 + 64 * (l * 32 + pm_), __ATOMIC_RELAXED, __HIP_MEMORY_SCOPE_AGENT) < 8u) { __builtin_amdgcn_s_sleep(1); if (++sp > (1u << 22)) break; }
                    __builtin_amdgcn_fence(__ATOMIC_ACQUIRE, "agent"); asm volatile("s_waitcnt vmcnt(0)" ::: "memory"); }
                __syncthreads();
            }
            OSched S; S.G = G; S.c = cb; S.nctx = l == 0 ? 128 : 0; S.A = (const char*)MM; S.B = (const char*)(ws + WS_WO + (size_t)l * 8 * MiB);
            ResEpi E; E.out = XS; E.xin = l == 0 ? (const void*)x : (const void*)XS; E.in_bf = l; E.cs_out = (float*)(ws + WS_PART); E.gate = modl + 4096; E.fuse = (l == 1 && fuse_final) ? 1 : 0; E.fout = out; E.fg = final_g; E.ctl = ws; E.PL = (LAS float*)(lds + LDS_X); pg8::gemm_phase(lds, DM, S, E);
        }
        if (!(l == 1 && fuse_final)) SEAM(P + 4);
    }
    if (IN(11) && !fuse_final) {
        for (int r = gw; r < ML; r += NGW) {
            float* src = out + (size_t)r * DM; f32x4 v[8]; float ss = 0.f;
#pragma unroll
            for (int j = 0; j < 8; ++j) { const u32x2 q = *(const u32x2*)(XS + (size_t)r * DM + j * 256 + lane * 4); v[j] = (f32x4){bf_lo(q.x), bf_hi(q.x), bf_lo(q.y), bf_hi(q.y)};
                ss += (v[j][0] * v[j][0] + v[j][1] * v[j][1]) + (v[j][2] * v[j][2] + v[j][3] * v[j][3]); }
            const float rstd = __builtin_amdgcn_rsqf(wave_sum(ss) * (1.f / DM) + EPS);
#pragma unroll
            for (int j = 0; j < 8; ++j) { const int col = j * 256 + lane * 4; const f32x4 g = *(const f32x4*)(final_g + col); f32x4 o = v[j] * rstd * g;
                *(f32x4*)(src + col) = o; }
        }
    }
#undef IN
#undef SEAM
}

extern "C" void kernel_launch(void* const* d_in, const int* in_sizes, int n_in, void* d_out, int out_size, void* d_ws, size_t ws_size, hipStream_t stream) {
    static int grid = 0;
    if (grid == 0) {
        if (n_in != 14 || in_sizes[0] != ML * DM || out_size != ML * DM || ws_size < WS_END) { fprintf(stderr, "kernel_launch: unexpected shapes (n_in %d, in0 %d, out %d, ws %zu < %zu)\n", n_in, n_in > 0 ? in_sizes[0] : -1, out_size, ws_size, (size_t)WS_END); grid = -1; return; }
        int dev = 0, cus = 0, per_cu = 0;
        hipGetDevice(&dev); hipDeviceGetAttribute(&cus, hipDeviceAttributeMultiprocessorCount, dev);
        if (hipFuncSetAttribute((const void*)mk_fwd, hipFuncAttributeMaxDynamicSharedMemorySize, LDS_BYTES) != hipSuccess) { fprintf(stderr, "kernel_launch: hipFuncSetAttribute failed\n"); grid = -1; return; }
        if (hipOccupancyMaxActiveBlocksPerMultiprocessor(&per_cu, (const void*)mk_fwd, 512, LDS_BYTES) != hipSuccess || per_cu < 1) { fprintf(stderr, "kernel_launch: occupancy query says %d\n", per_cu); per_cu = 1; }
        (void)hipGetLastError();
        grid = cus > 0 ? cus : 256;
    }
    if (grid < 0) return;
    Args a{};
    for (int i = 0; i < 14; ++i) a.in[i] = (const float*)d_in[i];
    a.out = (float*)d_out; a.ws = (unsigned char*)d_ws;
#if MK_ONE_LAUNCH
    a.ph_lo = 0; a.ph_hi = NPH;
    void* kargs[] = {&a};
    hipError_t e = hipLaunchCooperativeKernel((const void*)mk_fwd, dim3(grid), dim3(512), kargs, LDS_BYTES, stream);
    if (e != hipSuccess) fprintf(stderr, "kernel_launch: cooperative launch failed: %s (grid %d)\n", hipGetErrorString(e), grid);
#else
    for (int p = 0; p < NPH; ++p) {
        a.ph_lo = p; a.ph_hi = p + 1;
        hipLaunchKernelGGL(mk_fwd, dim3(grid), dim3(512), LDS_BYTES, stream, a);
    }
    hipError_t e = hipPeekAtLastError();
    if (e != hipSuccess) fprintf(stderr, "kernel_launch: launch failed: %s\n", hipGetErrorName(e));
#endif
}
```

```cpp
#include <hip/hip_runtime.h>
#include <hip/hip_cooperative_groups.h>
#include <cstdio>
#include <cstdint>
namespace cg = cooperative_groups;

#ifndef MK_ONE_LAUNCH
#define MK_ONE_LAUNCH 1
#endif
#ifndef MK_XCD_BAR
#define MK_XCD_BAR 1
#endif
#ifndef PROBE_REP
#define PROBE_REP (-1)
#endif
#define NREP(k) ((k) == PROBE_REP ? 2 : 1)


#define LAS __attribute__((address_space(3)))
typedef unsigned short bf16_t;
typedef short bf16x8 __attribute__((ext_vector_type(8)));
typedef short s16x4 __attribute__((ext_vector_type(4)));
typedef float f32x4 __attribute__((ext_vector_type(4)));
typedef float f32x16 __attribute__((ext_vector_type(16)));
typedef unsigned u32x4 __attribute__((ext_vector_type(4)));
typedef unsigned u32x2 __attribute__((ext_vector_type(2)));

constexpr int DM = 2048, NB = 4, SEQ = 2048, CTX = 256;
constexpr int ML = NB * SEQ, MC = NB * CTX, MT = ML + MC;
constexpr int INW = 9216, KEYS = SEQ + CTX;
constexpr int NPH = 12;
constexpr float EPS = 1e-6f;

constexpr size_t MiB = 1u << 20;
constexpr size_t WS_MOD = 1 * MiB;
constexpr size_t WS_TAB = 2 * MiB;
constexpr size_t WS_TT = 2 * MiB + 512 * 1024;
constexpr size_t WS_DM = 3 * MiB;
constexpr size_t WS_WIN = 19 * MiB;
constexpr size_t WS_WCAT = 95 * MiB;
constexpr size_t WS_WO = 111 * MiB;
constexpr size_t WS_H = 127 * MiB;
constexpr size_t WS_Q = 163 * MiB;
constexpr size_t WS_K = 190 * MiB;
constexpr size_t WS_V = 199 * MiB;
constexpr size_t WS_ZA = 208 * MiB;
constexpr size_t WS_ZB = 235 * MiB;
constexpr size_t WS_GA = 244 * MiB;
constexpr size_t WS_GB = 280 * MiB;
constexpr size_t WS_UT = 316 * MiB;
constexpr size_t WS_UTC = 332 * MiB;
constexpr size_t WS_WUB = 334 * MiB;
constexpr size_t WS_XS = 338 * MiB;
constexpr size_t WS_AA = 338 * MiB;
constexpr size_t WS_AB = 361 * MiB;
constexpr size_t WS_ACAT = 370 * MiB;
constexpr size_t WS_MM = 406 * MiB;
constexpr size_t WS_CS1 = 442 * MiB;
constexpr size_t WS_PART = 450 * MiB;
constexpr size_t WS_END = 514 * MiB;

constexpr int LDS_BYTES = 147456;
constexpr int LDS_X = 131072;
constexpr int LDS_MISC = 131072 + 8192;
constexpr int CW_CTXCNT = 3520;
constexpr size_t CTL_ZERO_BYTES = 16384;

__device__ __forceinline__ unsigned cvt_pk_bf16(float lo, float hi) { unsigned r; asm volatile("v_cvt_pk_bf16_f32 %0, %1, %2" : "=v"(r) : "v"(lo), "v"(hi)); return r; }
__device__ __forceinline__ float bf_lo(unsigned w) { return __uint_as_float(w << 16); }
__device__ __forceinline__ float bf_hi(unsigned w) { return __uint_as_float(w & 0xffff0000u); }
__device__ __forceinline__ float bf2f(bf16_t v) { return __uint_as_float((unsigned)v << 16); }
__device__ __forceinline__ unsigned f2bf(float f) { unsigned u = __builtin_bit_cast(unsigned, f); return (u + 0x7fffu + ((u >> 16) & 1u)) >> 16; }
__device__ __forceinline__ float sigmoidf_(float x) { return __builtin_amdgcn_rcpf(1.f + __builtin_amdgcn_exp2f(-1.4426950408889634f * x)); }
__device__ __forceinline__ int ufl(int v) { return __builtin_amdgcn_readfirstlane(v); }
__device__ __forceinline__ size_t ufl64(size_t v) { const unsigned lo = __builtin_amdgcn_readfirstlane((unsigned)v), hi = __builtin_amdgcn_readfirstlane((unsigned)(v >> 32)); return ((size_t)hi << 32) | lo; }
__device__ __forceinline__ float wave_sum(float v) {
#pragma unroll
    for (int o = 1; o < 64; o <<= 1) v += __shfl_xor(v, o);
    return v;
}

namespace pg8 {
constexpr int BM = 256, BK = 64, HALF = 128, HTB = HALF * BK * 2, STAGE_BYTES = 8 * HTB;
__host__ __device__ __forceinline__ int lds_byte(int r, int c) { const int st = (r >> 4) * 2 + (c >> 5), rr = r & 15, cc = c & 31, ob = rr * 64 + cc * 2; return st * 1024 + (ob ^ (((ob >> 9) & 1) << 5)); }
__host__ __device__ __forceinline__ void stage_rc(int b, int& R, int& C) { const int st = b / 1024, sb = b % 1024, swz = sb ^ (((sb >> 9) & 1) << 5); R = (st >> 1) * 16 + swz / 64; C = (st & 1) * 32 + (swz % 64) / 2; }
__host__ __device__ __forceinline__ int perm32(int rho) { const int n = rho >> 4, i = rho & 15; return 8 * (i >> 2) + 4 * n + (i & 3); }

struct Unit { int kind, pm, pn, nt, keep; const char* a; const char* b; };

__device__ __forceinline__ void tile_decode(int L, int nM, int nN, int& pm, int& pn) {
    const int nwg = nM * nN; int wgid = L;
    { const int q = nwg / 8, r = nwg % 8, xcd = wgid % 8, off = wgid / 8; wgid = (xcd < r ? xcd * (q + 1) : r * (q + 1) + (xcd - r) * q) + off; }
    const int nig = 8 * nN, gid = wgid / nig, fm = gid * 8, gsz = (nM - fm) < 8 ? (nM - fm) : 8;
    pm = fm + ((wgid % nig) % gsz); pn = (wgid % nig) / gsz;
}

template <class Epi, class Sched>
__device__ __forceinline__ void gemm_phase(LAS unsigned char* lds, const int K, const Sched& S, const Epi& E) {
    int tid = threadIdx.x; asm volatile("" : "+v"(tid));
    const int wid = __builtin_amdgcn_readfirstlane(tid >> 6), lane = tid & 63, wr = wid >> 2, wc = wid & 3, fr = lane & 15, fq = lane >> 4;
    unsigned voffA[2], voffB[2];
#pragma unroll
    for (int i = 0; i < 2; ++i) { int R, C; stage_rc(tid * 16 + i * 8192, R, C); const int Rb = (R & ~31) + perm32(R & 31);
        voffA[i] = (unsigned)(R * K + C) * 2u; voffB[i] = (unsigned)(Rb * K + C) * 2u; }
    const size_t kstep = (size_t)(BK * 2);
    const size_t hstep = (size_t)HALF * K * 2;
    const unsigned ldsw = (unsigned)wid * 1024u;
    const int aoff = lds_byte(wr * 64 + fr, fq * 8), boff = lds_byte(wc * 32 + fr, fq * 8);
#define PG8_SA(b, h) (((b) * 2 + (h)) * HTB)
#define PG8_SB(b, h) ((4 + (b) * 2 + (h)) * HTB)
#define PG8_STAGE(bufoff, gbase, voff) do { _Pragma("unroll") for (int _i = 0; _i < 2; ++_i) \
        __builtin_amdgcn_global_load_lds((const unsigned*)((const char*)(gbase) + (voff)[_i]), (LAS unsigned*)(lds + (bufoff) + ldsw + _i * 8192), 16, 0, 0); } while (0)
#define PG8_LDA(dst, b, h) do { _Pragma("unroll") for (int m = 0; m < 4; ++m) _Pragma("unroll") for (int k = 0; k < 2; ++k) dst[m][k] = *(const LAS bf16x8*)(lds + PG8_SA(b, h) + aoff + m * 2048 + k * 1024); } while (0)
#define PG8_LDB(dst, b, h) do { _Pragma("unroll") for (int n = 0; n < 2; ++n) _Pragma("unroll") for (int k = 0; k < 2; ++k) dst[n][k] = *(const LAS bf16x8*)(lds + PG8_SB(b, h) + boff + n * 2048 + k * 1024); } while (0)
#define PG8_MMA(ai, bj, At, Bt) do { __builtin_amdgcn_s_setprio(1); _Pragma("unroll") for (int m = 0; m < 4; ++m) _Pragma("unroll") for (int n = 0; n < 2; ++n) _Pragma("unroll") for (int k = 0; k < 2; ++k) \
        acc[ai][bj][m][n] = __builtin_amdgcn_mfma_f32_16x16x32_bf16(Bt[n][k], At[m][k], acc[ai][bj][m][n], 0, 0, 0); __builtin_amdgcn_s_setprio(0); } while (0)
#define PG8_WAIT_V(n) asm volatile("s_waitcnt vmcnt(" #n ")" ::: "memory")
#define PG8_WAIT_L(n) asm volatile("s_waitcnt lgkmcnt(" #n ")" ::: "memory")
#define PG8_BAR __builtin_amdgcn_s_barrier()
#define PG8_SCHED __builtin_amdgcn_sched_barrier(0)
    Unit cur, nxt; int ui = 0; cur.keep = 0;
    if (!S.next(0, cur)) return;
    f32x4 acc[2][2][4][2];
#pragma unroll
    for (int a = 0; a < 2; ++a)
#pragma unroll
        for (int b = 0; b < 2; ++b)
#pragma unroll
            for (int m = 0; m < 4; ++m)
#pragma unroll
                for (int n = 0; n < 2; ++n) acc[a][b][m][n] = (f32x4){0.f, 0.f, 0.f, 0.f};
    bf16x8 At[4][2], B0[2][2], B1[2][2];
    const char* cA = cur.a; const char* cB = cur.b;
    PG8_STAGE(PG8_SB(0, 0), cB, voffB); PG8_STAGE(PG8_SB(0, 1), cB + hstep, voffB); PG8_STAGE(PG8_SA(0, 0), cA, voffA); PG8_STAGE(PG8_SA(0, 1), cA + hstep, voffA);
    if (wr == 1) PG8_BAR;
    PG8_WAIT_V(2); PG8_BAR;
    PG8_STAGE(PG8_SB(1, 0), cB + kstep, voffB); PG8_STAGE(PG8_SA(1, 0), cA + kstep, voffA); PG8_STAGE(PG8_SB(1, 1), cB + hstep + kstep, voffB);
    PG8_WAIT_V(6); PG8_BAR;
    for (;;) {
        nxt.keep = 0;
        const bool has_next = S.next(ui + 1, nxt);
        const char* nA = has_next ? nxt.a : cA; const char* nB = has_next ? nxt.b : cB;
        const int nt = cur.nt;
        for (int t = 0; t < nt; t += 2) {
            if constexpr (Epi::HAS_MID) { if (t == Epi::MID_T) E.mid(acc, cur, wr, wc, fr, fq); }
            const bool last = (t == nt - 2);
            const char* a1 = cA + (size_t)(t + 1) * kstep;
            const char* a2 = last ? nA : cA + (size_t)(t + 2) * kstep; const char* b2 = last ? nB : cB + (size_t)(t + 2) * kstep;
            const char* a3 = a2 + kstep; const char* b3 = b2 + kstep;
            PG8_LDB(B0, 0, 0); PG8_LDB(B1, 0, 1); PG8_SCHED; PG8_LDA(At, 0, 0); PG8_STAGE(PG8_SA(1, 1), a1 + hstep, voffA);
            PG8_WAIT_V(8); PG8_WAIT_L(0); PG8_BAR; PG8_MMA(0, 0, At, B0); PG8_MMA(0, 1, At, B1); PG8_BAR; PG8_SCHED;
            PG8_LDA(At, 0, 1); PG8_STAGE(PG8_SB(0, 0), b2, voffB); PG8_STAGE(PG8_SB(0, 1), b2 + hstep, voffB); PG8_STAGE(PG8_SA(0, 0), a2, voffA);
            PG8_WAIT_V(8); PG8_WAIT_L(0); PG8_BAR; PG8_MMA(1, 0, At, B0); PG8_MMA(1, 1, At, B1); PG8_BAR; PG8_SCHED;
            PG8_LDB(B0, 1, 0); PG8_LDB(B1, 1, 1); PG8_SCHED; PG8_LDA(At, 1, 0); PG8_STAGE(PG8_SA(0, 1), a2 + hstep, voffA);
            PG8_WAIT_V(8); PG8_WAIT_L(0); PG8_BAR; PG8_MMA(0, 0, At, B0); PG8_MMA(0, 1, At, B1); PG8_BAR; PG8_SCHED;
            PG8_LDA(At, 1, 1); PG8_STAGE(PG8_SB(1, 0), b3, voffB); PG8_STAGE(PG8_SB(1, 1), b3 + hstep, voffB); PG8_STAGE(PG8_SA(1, 0), a3, voffA);
            PG8_WAIT_V(8); PG8_WAIT_L(0); PG8_BAR; PG8_MMA(1, 0, At, B0); PG8_MMA(1, 1, At, B1); PG8_BAR; PG8_SCHED;
        }
        if (wr == 0) PG8_BAR;
        E(acc, cur, wr, wc, fr, fq);
        if (!has_next) break;
        if (!nxt.keep) {
#pragma unroll
        for (int a = 0; a < 2; ++a)
#pragma unroll
            for (int b = 0; b < 2; ++b)
#pragma unroll
                for (int m = 0; m < 4; ++m)
#pragma unroll
                    for (int n = 0; n < 2; ++n) acc[a][b][m][n] = (f32x4){0.f, 0.f, 0.f, 0.f};
        }
        cur = nxt; cA = nA; cB = nB; ++ui;
        if (wr == 1) PG8_BAR;
    }
    PG8_WAIT_V(0);
    PG8_BAR;
#undef PG8_SA
#undef PG8_SB
#undef PG8_STAGE
#undef PG8_LDA
#undef PG8_LDB
#undef PG8_MMA
#undef PG8_WAIT_V
#undef PG8_WAIT_L
#undef PG8_BAR
#undef PG8_SCHED
}

typedef const f32x4 (&AccRef)[2][2][4][2];

__device__ __forceinline__ void epi_act(AccRef acc, bf16_t* O, int ld, int act, int wr, int wc, int fr, int fq) {
#pragma unroll
    for (int ai = 0; ai < 2; ++ai)
#pragma unroll
        for (int m = 0; m < 4; ++m) { bf16_t* rowp = O + (size_t)(ai * HALF + wr * 64 + m * 16 + fr) * ld + wc * 32 + 8 * fq;
#pragma unroll
            for (int bj = 0; bj < 2; ++bj) { f32x4 v0 = acc[ai][bj][m][0], v1 = acc[ai][bj][m][1];
                if (act != 0) {
#pragma unroll
                    for (int e = 0; e < 4; ++e) { const float s0 = sigmoidf_(v0[e]), s1 = sigmoidf_(v1[e]); v0[e] = act == 1 ? v0[e] * s0 : s0; v1[e] = act == 1 ? v1[e] * s1 : s1; } }
                u32x4 w; w.x = cvt_pk_bf16(v0[0], v0[1]); w.y = cvt_pk_bf16(v0[2], v0[3]); w.z = cvt_pk_bf16(v1[0], v1[1]); w.w = cvt_pk_bf16(v1[2], v1[3]);
                *(u32x4*)(rowp + bj * HALF) = w; }
            if (m & 1) asm volatile("" ::: "memory"); }
}
__device__ __forceinline__ void epi_qk(AccRef acc, bf16_t* O, int ld, const float* g, const float* rope, int tok0, LAS float* X, int wr, int wc, int fr, int fq) {
#pragma unroll
    for (int ai = 0; ai < 2; ++ai)
#pragma unroll
        for (int m = 0; m < 4; ++m)
#pragma unroll
            for (int bj = 0; bj < 2; ++bj) { const f32x4 a = acc[ai][bj][m][0], b = acc[ai][bj][m][1];
                float s = (a[0] * a[0] + a[1] * a[1]) + (a[2] * a[2] + a[3] * a[3]) + (b[0] * b[0] + b[1] * b[1]) + (b[2] * b[2] + b[3] * b[3]);
                s += __shfl_xor(s, 16); s += __shfl_xor(s, 32);
                if (fq == 0) X[((ai * HALF + wr * 64 + m * 16 + fr) * 2 + bj) * 4 + wc] = s; }
    asm volatile("s_waitcnt lgkmcnt(0)" ::: "memory"); __builtin_amdgcn_s_barrier(); asm volatile("" ::: "memory");
    const int axis = wc >> 1, f0 = (wc & 1) * 16 + 4 * fq;
    const f32x4 g1 = *(const f32x4*)(g + axis * 64 + f0), g2 = *(const f32x4*)(g + axis * 64 + 32 + f0);
#pragma unroll
    for (int ai = 0; ai < 2; ++ai)
#pragma unroll
        for (int m = 0; m < 4; ++m) { const int rowl = ai * HALF + wr * 64 + m * 16 + fr;
            f32x4 cs0 = (f32x4){1.f, 0.f, 1.f, 0.f}, cs1 = cs0;
            if (rope) { const int n = tok0 + rowl, pos = axis ? (n & 63) : (n >> 6); const float* p = rope + (pos * 32 + f0) * 2; cs0 = *(const f32x4*)p; cs1 = *(const f32x4*)(p + 4); }
            const float co[4] = {cs0[0], cs0[2], cs1[0], cs1[2]}, si[4] = {cs0[1], cs0[3], cs1[1], cs1[3]};
#pragma unroll
            for (int bj = 0; bj < 2; ++bj) { const f32x4 part = *(const LAS f32x4*)(X + (rowl * 2 + bj) * 4);
                const float rstd = __builtin_amdgcn_rsqf(((part[0] + part[1]) + (part[2] + part[3])) * (1.f / 128.f) + EPS);
                const f32x4 x1 = acc[ai][bj][m][0] * rstd * g1, x2 = acc[ai][bj][m][1] * rstd * g2; float o1[4], o2[4];
#pragma unroll
                for (int e = 0; e < 4; ++e) { o1[e] = x1[e] * co[e] - x2[e] * si[e]; o2[e] = x2[e] * co[e] + x1[e] * si[e]; }
                u32x4 w; w.x = cvt_pk_bf16(o1[0], o1[1]); w.y = cvt_pk_bf16(o1[2], o1[3]); w.z = cvt_pk_bf16(o2[0], o2[1]); w.w = cvt_pk_bf16(o2[2], o2[3]);
                *(u32x4*)(O + (size_t)rowl * ld + bj * HALF + wc * 32 + 8 * fq) = w; }
            asm volatile("" ::: "memory"); }
}
__device__ __forceinline__ void epi_mul(AccRef acc, bf16_t* O, int ldo, const bf16_t* A1, int ld, int wr, int wc, int fr, int fq) {
#pragma unroll
    for (int ai = 0; ai < 2; ++ai)
#pragma unroll
        for (int m = 0; m < 4; ++m) { const int rl = ai * HALF + wr * 64 + m * 16 + fr, cl = wc * 32 + 8 * fq;
#pragma unroll
            for (int bj = 0; bj < 2; ++bj) { const u32x4 q1 = *(const u32x4*)(A1 + (size_t)rl * ld + cl + bj * HALF);
                f32x4 v0 = acc[ai][bj][m][0], v1 = acc[ai][bj][m][1];
                v0[0] *= bf_lo(q1.x); v0[1] *= bf_hi(q1.x); v0[2] *= bf_lo(q1.y); v0[3] *= bf_hi(q1.y); v1[0] *= bf_lo(q1.z); v1[1] *= bf_hi(q1.z); v1[2] *= bf_lo(q1.w); v1[3] *= bf_hi(q1.w);
                u32x4 w; w.x = cvt_pk_bf16(v0[0], v0[1]); w.y = cvt_pk_bf16(v0[2], v0[3]); w.z = cvt_pk_bf16(v1[0], v1[1]); w.w = cvt_pk_bf16(v1[2], v1[3]);
                *(u32x4*)(O + (size_t)rl * ldo + cl + bj * HALF) = w; }
            if (m == 3) asm volatile("" ::: "memory"); }
}
__device__ __forceinline__ void epi_ratio(f32x4 (&acc)[2][2][4][2], const bf16_t* GAo, const bf16_t* GBo, int wr, int wc, int fr, int fq) {
#pragma unroll
    for (int ai = 0; ai < 2; ++ai)
#pragma unroll
        for (int m = 0; m < 4; ++m) { const size_t ro = (size_t)(ai * HALF + wr * 64 + m * 16 + fr) * DM + wc * 32 + 8 * fq;
#pragma unroll
            for (int bj = 0; bj < 2; ++bj) { const u32x4 qa = *(const u32x4*)(GAo + ro + bj * HALF), qb = *(const u32x4*)(GBo + ro + bj * HALF);
                f32x4& v0 = acc[ai][bj][m][0]; f32x4& v1 = acc[ai][bj][m][1];
                v0[0] *= bf_lo(qb.x) * __builtin_amdgcn_rcpf(bf_lo(qa.x)); v0[1] *= bf_hi(qb.x) * __builtin_amdgcn_rcpf(bf_hi(qa.x));
                v0[2] *= bf_lo(qb.y) * __builtin_amdgcn_rcpf(bf_lo(qa.y)); v0[3] *= bf_hi(qb.y) * __builtin_amdgcn_rcpf(bf_hi(qa.y));
                v1[0] *= bf_lo(qb.z) * __builtin_amdgcn_rcpf(bf_lo(qa.z)); v1[1] *= bf_hi(qb.z) * __builtin_amdgcn_rcpf(bf_hi(qa.z));
                v1[2] *= bf_lo(qb.w) * __builtin_amdgcn_rcpf(bf_lo(qa.w)); v1[3] *= bf_hi(qb.w) * __builtin_amdgcn_rcpf(bf_hi(qa.w)); }
            if (m == 3) asm volatile("" ::: "memory"); }
}
__device__ __forceinline__ void epi_m1(f32x4 (&acc)[2][2][4][2], bf16_t* O, const bf16_t* NUM, const bf16_t* DEN, bool store, int wr, int wc, int fr, int fq) {
#pragma unroll
    for (int ai = 0; ai < 2; ++ai)
#pragma unroll
        for (int m = 0; m < 4; ++m) { const size_t ro = (size_t)(ai * HALF + wr * 64 + m * 16 + fr) * DM + wc * 32 + 8 * fq;
#pragma unroll
            for (int bj = 0; bj < 2; ++bj) { const u32x4 qn = *(const u32x4*)(NUM + ro + bj * HALF);
                float f[8] = {bf_lo(qn.x), bf_hi(qn.x), bf_lo(qn.y), bf_hi(qn.y), bf_lo(qn.z), bf_hi(qn.z), bf_lo(qn.w), bf_hi(qn.w)};
                if (DEN) { const u32x4 qd = *(const u32x4*)(DEN + ro + bj * HALF);
                    const float d[8] = {bf_lo(qd.x), bf_hi(qd.x), bf_lo(qd.y), bf_hi(qd.y), bf_lo(qd.z), bf_hi(qd.z), bf_lo(qd.w), bf_hi(qd.w)};
#pragma unroll
                    for (int e = 0; e < 8; ++e) f[e] *= __builtin_amdgcn_rcpf(d[e]); }
                f32x4& v0 = acc[ai][bj][m][0]; f32x4& v1 = acc[ai][bj][m][1];
                v0[0] *= f[0]; v0[1] *= f[1]; v0[2] *= f[2]; v0[3] *= f[3]; v1[0] *= f[4]; v1[1] *= f[5]; v1[2] *= f[6]; v1[3] *= f[7];
                if (store) { u32x4 w; w.x = cvt_pk_bf16(v0[0], v0[1]); w.y = cvt_pk_bf16(v0[2], v0[3]); w.z = cvt_pk_bf16(v1[0], v1[1]); w.w = cvt_pk_bf16(v1[2], v1[3]);
                    *(u32x4*)(O + ro + bj * HALF) = w; } }
            if (m == 3) asm volatile("" ::: "memory"); }
}
template <bool IN_BF>
__device__ __forceinline__ void epi_res(AccRef acc, bf16_t* O, const void* Xin, const float* gate, int wr, int wc, int fr, int fq) {
    f32x4 gv[2][2];
#pragma unroll
    for (int bj = 0; bj < 2; ++bj)
#pragma unroll
        for (int n = 0; n < 2; ++n) gv[bj][n] = *(const f32x4*)(gate + bj * HALF + wc * 32 + 8 * fq + 4 * n);
#pragma unroll
    for (int ai = 0; ai < 2; ++ai)
#pragma unroll
        for (int m = 0; m < 4; ++m) { const size_t ro = (size_t)(ai * HALF + wr * 64 + m * 16 + fr) * DM + wc * 32 + 8 * fq;
#pragma unroll
            for (int bj = 0; bj < 2; ++bj) { const size_t off = ro + bj * HALF; f32x4 x0, x1;
                if (IN_BF) { const u32x4 q = *(const u32x4*)((const bf16_t*)Xin + off); x0 = (f32x4){bf_lo(q.x), bf_hi(q.x), bf_lo(q.y), bf_hi(q.y)}; x1 = (f32x4){bf_lo(q.z), bf_hi(q.z), bf_lo(q.w), bf_hi(q.w)}; }
                else { x0 = *(const f32x4*)((const float*)Xin + off); x1 = *(const f32x4*)((const float*)Xin + off + 4); }
                const f32x4 o0 = x0 + gv[bj][0] * acc[ai][bj][m][0], o1 = x1 + gv[bj][1] * acc[ai][bj][m][1];
                u32x4 w; w.x = cvt_pk_bf16(o0[0], o0[1]); w.y = cvt_pk_bf16(o0[2], o0[3]); w.z = cvt_pk_bf16(o1[0], o1[1]); w.w = cvt_pk_bf16(o1[2], o1[3]);
                *(u32x4*)(O + off) = w; }
            if (m == 3) asm volatile("" ::: "memory"); }
}
__device__ __forceinline__ void epi_res_final(f32x4 (&acc)[2][2][4][2], const bf16_t* Xin, const float* gate, float* Fo, const float* fg, float* slots, unsigned* cnt, int pn, LAS float* PL, int wr, int wc, int fr, int fq) {
    int tid = threadIdx.x; asm volatile("" : "+v"(tid));
    const int wid = __builtin_amdgcn_readfirstlane(tid >> 6), lane = tid & 63;
    {   f32x4 gv[2][2];
#pragma unroll
        for (int bj = 0; bj < 2; ++bj)
#pragma unroll
            for (int n = 0; n < 2; ++n) gv[bj][n] = *(const f32x4*)(gate + bj * HALF + wc * 32 + 8 * fq + 4 * n);
#pragma unroll
        for (int ai = 0; ai < 2; ++ai)
#pragma unroll
            for (int m = 0; m < 4; ++m) { const size_t ro = (size_t)(ai * HALF + wr * 64 + m * 16 + fr) * DM + wc * 32 + 8 * fq; float s = 0.f;
#pragma unroll
                for (int bj = 0; bj < 2; ++bj) { const u32x4 q = *(const u32x4*)(Xin + ro + bj * HALF);
                    const f32x4 x0 = (f32x4){bf_lo(q.x), bf_hi(q.x), bf_lo(q.y), bf_hi(q.y)}, x1 = (f32x4){bf_lo(q.z), bf_hi(q.z), bf_lo(q.w), bf_hi(q.w)};
                    const f32x4 o0 = x0 + gv[bj][0] * acc[ai][bj][m][0], o1 = x1 + gv[bj][1] * acc[ai][bj][m][1];
                    acc[ai][bj][m][0] = o0; acc[ai][bj][m][1] = o1;
                    s += (o0[0] * o0[0] + o0[1] * o0[1]) + (o0[2] * o0[2] + o0[3] * o0[3]) + (o1[0] * o1[0] + o1[1] * o1[1]) + (o1[2] * o1[2] + o1[3] * o1[3]); }
                s += __shfl_xor(s, 16); s += __shfl_xor(s, 32);
                if (fq == 0) PL[(ai * HALF + wr * 64 + m * 16 + fr) * 4 + wc] = s;
                if (m == 3) asm volatile("" ::: "memory"); }
    }
    asm volatile("s_waitcnt lgkmcnt(0)" ::: "memory"); __builtin_amdgcn_s_barrier(); asm volatile("" ::: "memory");
    const int row = wid * 32 + (lane & 31);
    if (lane < 32) { const f32x4 p = *(const LAS f32x4*)(PL + row * 4); __hip_atomic_store(slots + row * 8 + pn, (p[0] + p[1]) + (p[2] + p[3]), __ATOMIC_RELAXED, __HIP_MEMORY_SCOPE_AGENT); }
    asm volatile("s_waitcnt vmcnt(0)" ::: "memory");
    if (lane == 0) (void)__hip_atomic_fetch_add(cnt, 1u, __ATOMIC_RELAXED, __HIP_MEMORY_SCOPE_AGENT);
    if (wid == 0) { unsigned sp = 0;
        while ((unsigned)__builtin_amdgcn_readfirstlane(__hip_atomic_load(cnt, __ATOMIC_RELAXED, __HIP_MEMORY_SCOPE_AGENT)) < 64u) { __builtin_amdgcn_s_sleep(2); if (++sp > (1u << 21)) break; }
        __builtin_amdgcn_fence(__ATOMIC_ACQUIRE, "agent"); }
    asm volatile("s_waitcnt vmcnt(0) lgkmcnt(0)" ::: "memory"); __builtin_amdgcn_s_barrier(); asm volatile("" ::: "memory");
    if (lane < 32) { float t = 0.f;
#pragma unroll
        for (int k = 0; k < 8; ++k) t += __hip_atomic_load(slots + row * 8 + k, __ATOMIC_RELAXED, __HIP_MEMORY_SCOPE_AGENT);
        PL[1024 + row] = __builtin_amdgcn_rsqf(t * (1.f / DM) + EPS); }
    asm volatile("s_waitcnt vmcnt(0) lgkmcnt(0)" ::: "memory"); __builtin_amdgcn_s_barrier(); asm volatile("" ::: "memory");
    {   f32x4 gf[2][2];
#pragma unroll
        for (int bj = 0; bj < 2; ++bj)
#pragma unroll
            for (int n = 0; n < 2; ++n) gf[bj][n] = *(const f32x4*)(fg + bj * HALF + wc * 32 + 8 * fq + 4 * n);
#pragma unroll
        for (int ai = 0; ai < 2; ++ai)
#pragma unroll
            for (int m = 0; m < 4; ++m) { const int rl = ai * HALF + wr * 64 + m * 16 + fr; const float rstd = PL[1024 + rl]; float* op = Fo + (size_t)rl * DM + wc * 32 + 8 * fq;
#pragma unroll
                for (int bj = 0; bj < 2; ++bj)
#pragma unroll
                    for (int n = 0; n < 2; ++n) *(f32x4*)(op + bj * HALF + 4 * n) = acc[ai][bj][m][n] * rstd * gf[bj][n]; }
    }
}
}

enum { KQ = 0, KK = 1, KACT = 2, KUB = 3 };
struct G1Sched {
    int Gq, cq, nM, nA, n1, n2, Lbase, Lend, split; const char* H; const char* W;
    __device__ __forceinline__ bool next(int i, pg8::Unit& u) const {
        if (cq < 0 || cq >= Gq) return false;
        int L = Lbase + i * Gq + cq; if (L >= Lend) return false;
        u.nt = DM / 64;
        if (L < nA) { int pm, j; pg8::tile_decode(L, nM, 18, pm, j); const int pn = ufl(j < 16 ? j : j + 4); pm = ufl(pm);
            u.kind = pn < 6 ? KQ : (pn < 8 ? KK : KACT); u.pm = pm; u.pn = pn; u.a = H + (size_t)pm * MiB; u.b = W + (size_t)pn * MiB; return true; }
        L -= nA;
        if (L < n1) { int pc, tt; pg8::tile_decode(L, 4, nM, pc, tt); pc = ufl(pc); tt = ufl(tt); u.kind = KUB; u.pm = pc; u.pn = tt; u.a = W + (size_t)(16 + pc) * MiB; u.b = H + (size_t)tt * MiB; return true; }
        L -= n1;
        if (L < n2) { const int pm = 32 + (L & 3), pn = 6 + (L >> 2); u.kind = pn < 8 ? KK : KACT; u.pm = pm; u.pn = pn; u.a = H + (size_t)pm * MiB; u.b = W + (size_t)pn * MiB; return true; }
        L -= n2;
        int pm, j, pn;
        if (!split) { pg8::tile_decode(L, nM, 16, pm, j); pn = 22 + j; }
        else if (L < (nM - 6) * 16) { pg8::tile_decode(L, nM - 6, 16, pm, j); pm += 6; pn = 22 + j; }
        else if (L < (nM - 6) * 16 + 8) { pm = 5; pn = 22 + (L - (nM - 6) * 16); }
        else if (L < (nM - 6) * 16 + 8 + 80) { pg8::tile_decode(L - (nM - 6) * 16 - 8, 5, 16, pm, j); pn = 22 + j; }
        else { pm = 5; pn = 30 + (L - (nM - 6) * 16 - 88); }
        pm = ufl(pm); pn = ufl(pn); u.kind = KACT; u.pm = pm; u.pn = pn; u.a = H + (size_t)pm * MiB; u.b = W + (size_t)pn * MiB; return true;
    }
};
struct G1Epi {
    static constexpr bool HAS_MID = false; static constexpr int MID_T = 0;
    unsigned char* ws; const float *qg, *kg; LAS float* X;
    __device__ __forceinline__ void operator()(pg8::AccRef acc, const pg8::Unit& u, int wr, int wc, int fr, int fq) const {
        asm volatile("" : "+v"(fr), "+v"(fq));
        const int pm = u.pm, pn = u.pn; const float* rope = (const float*)(ws + WS_TAB);
        if (u.kind == KQ) {
            pg8::epi_qk(acc, (bf16_t*)(ws + WS_Q) + (size_t)pm * 256 * 1536 + pn * 256, 1536, qg, pm < 32 ? rope : nullptr, (pm & 7) * 256, X, wr, wc, fr, fq);
        } else if (u.kind == KK) {
            const int kvrow0 = pm < 32 ? pm * 256 + (pm >> 3) * 256 : (pm - 32) * KEYS + SEQ;
            pg8::epi_qk(acc, (bf16_t*)(ws + WS_K) + (size_t)kvrow0 * 512 + (pn - 6) * 256, 512, kg, pm < 32 ? rope : nullptr, (pm & 7) * 256, X, wr, wc, fr, fq);
        } else {
            bf16_t* O; int ld, act = 0;
            if (u.kind == KUB) { const int cs = pm >> 1, chb = (pm & 1) * 256;
                if (pn < 32) { O = (bf16_t*)(ws + WS_UT) + ((size_t)((pn >> 3) * 512 + chb)) * 4096 + cs * 2048 + (pn & 7) * 256; ld = 4096; }
                else { O = (bf16_t*)(ws + WS_UTC) + ((size_t)((pn - 32) * 512 + chb)) * 512 + cs * 256; ld = 512; } }
            else if (pn < 10) { const int kvrow0 = pm < 32 ? pm * 256 + (pm >> 3) * 256 : (pm - 32) * KEYS + SEQ; O = (bf16_t*)(ws + WS_V) + (size_t)kvrow0 * 512 + (pn - 8) * 256; ld = 512; }
            else if (pn < 16) { O = (bf16_t*)(ws + WS_ZA) + (size_t)pm * 256 * 1536 + (pn - 10) * 256; ld = 1536; act = 1; }
            else if (pn < 22) { O = (bf16_t*)(ws + WS_ZB) + (size_t)pm * 256 * 512 + (pn - 20) * 256; ld = 512; act = 1; }
            else if (pn < 30) { O = (bf16_t*)(ws + WS_GA) + (size_t)pm * 256 * 2048 + (pn - 22) * 256; ld = 2048; act = 2; }
            else { O = (bf16_t*)(ws + WS_GB) + (size_t)pm * 256 * 2048 + (pn - 30) * 256; ld = 2048; act = 2; }
            pg8::epi_act(acc, O, ld, act, wr, wc, fr, fq);
        }
    }
};
struct GridSched {
    int G, c, nM, nN, nt; const char* A; const char* B; size_t astep, bstep;
    __device__ __forceinline__ bool next(int i, pg8::Unit& u) const {
        const int L = i * G + c; if (L >= nM * nN) return false;
        int pm, pn; pg8::tile_decode(L, nM, nN, pm, pn); pm = ufl(pm); pn = ufl(pn); u.kind = 0; u.nt = nt; u.pm = pm; u.pn = pn; u.a = A + (size_t)pm * astep; u.b = B + (size_t)pn * bstep; return true;
    }
};
struct FnSched {
    int G, c, cu0, nunits, ntn, nt; const char* A; const char* B; size_t astep, bstep, bbatch; int row_base, rows_per_b;
    __device__ __forceinline__ bool next(int i, pg8::Unit& u) const {
        const int L = ufl(i * G + ((c - cu0 + 4 * G) % G)); if (L >= nunits) return false;
        const int pn = L & 1, pmn = ufl((L >> 1) % ntn), b = ufl((L >> 1) / ntn);
        u.kind = 0; u.nt = nt; u.pm = row_base + b * rows_per_b + pmn * 256;   u.pn = pn; u.a = A + (size_t)pmn * astep; u.b = B + (size_t)b * bbatch + (size_t)pn * bstep; return true;
    }
};
struct FnEpi {
    static constexpr bool HAS_MID = false; static constexpr int MID_T = 0;
    bf16_t* ACAT; const bf16_t* ZB;
    __device__ __forceinline__ void operator()(pg8::AccRef acc, const pg8::Unit& u, int wr, int wc, int fr, int fq) const {
        asm volatile("" : "+v"(fr), "+v"(fq));
        pg8::epi_mul(acc, ACAT + (size_t)u.pm * DM + u.pn * 256, DM, ZB + (size_t)u.pm * 512 + u.pn * 256, 512, wr, wc, fr, fq);
    }
};
__device__ __forceinline__ void m1_sub(pg8::Unit& u, int pm, int pn, int sub, int odd, const char* A, const char* B) {
    const bool ybpart = (sub == 0) != (odd != 0);
    u.pm = pm; u.pn = pn; u.nt = ybpart ? 8 : 24; const size_t ko = ybpart ? 0 : 1024;
    u.a = A + (size_t)pm * MiB + ko; u.b = B + (size_t)pn * MiB + ko; u.keep = sub; u.kind = sub * 2 + odd;
}
struct M1Sched {
    int G, c, nM; const char* A; const char* B;
    __device__ __forceinline__ bool next(int i, pg8::Unit& u) const {
        const int L = (i >> 1) * G + c; if (L >= nM * 8) return false;
        int pm, pn; pg8::tile_decode(L, nM, 8, pm, pn); m1_sub(u, ufl(pm), ufl(pn), i & 1, c & 1, A, B); return true;
    }
};
struct M1Epi {
    static constexpr bool HAS_MID = false; static constexpr int MID_T = 0;
    bf16_t* MMo; const bf16_t* GA; const bf16_t* GB;
    __device__ __forceinline__ void operator()(f32x4 (&acc)[2][2][4][2], const pg8::Unit& u, int wr, int wc, int fr, int fq) const {
        asm volatile("" : "+v"(fr), "+v"(fq));
        const size_t o = (size_t)u.pm * 256 * DM + u.pn * 256;
        const bool odd = u.kind & 1, fin = u.kind >= 2;
        const bf16_t* num = (fin ? (odd ? GB : GA) : (odd ? GA : GB)) + o; const bf16_t* den = fin ? nullptr : (odd ? GB : GA) + o;
        pg8::epi_m1(acc, MMo + o, num, den, fin, wr, wc, fr, fq);
    }
};
struct CtxM1Sched {
    int cq; const char* A; const char* B;
    __device__ __forceinline__ bool next(int i, pg8::Unit& u) const {
        if (i > 1 || cq < 0 || cq >= 32) return false;
        m1_sub(u, 32 + (cq >> 3), cq & 7, i, cq & 1, A, B); return true;
    }
};
struct FoldSched {
    int G, c; const char* Tt; const char* Wub;
    __device__ __forceinline__ bool next(int i, pg8::Unit& u) const {
        const int L = i * G + c; if (L >= 64) return false;
        int two = 2; asm volatile("" : "+s"(two));
        u.kind = 0; u.nt = two; u.pm = L >> 3; u.pn = L & 7; u.a = Tt; u.b = Wub + (size_t)(L >> 3) * (512 * 1024) + (size_t)(L & 7) * 65536; return true;
    }
};
struct FoldEpi {
    static constexpr bool HAS_MID = false; static constexpr int MID_T = 0;
    unsigned char* ws;
    __device__ __forceinline__ void operator()(pg8::AccRef acc, const pg8::Unit& u, int wr, int wc, int fr, int fq) const {
        asm volatile("" : "+v"(fr), "+v"(fq));
        const int l2 = u.pm >> 2, g = u.pm & 3; bf16_t* WT = (bf16_t*)(ws + WS_WIN + (size_t)l2 * 38 * MiB) + (size_t)(4096 + g * 128) * DM + u.pn * 256;
#pragma unroll
        for (int ai = 0; ai < 2; ++ai)
#pragma unroll
            for (int m = 0; m < 4; ++m) { bf16_t* rowp = WT + (size_t)(ai * 512 + wr * 64 + m * 16 + fr) * DM + wc * 32 + 8 * fq;
#pragma unroll
                for (int bj = 0; bj < 2; ++bj) { const f32x4 v0 = acc[ai][bj][m][0], v1 = acc[ai][bj][m][1];
                    u32x4 w; w.x = cvt_pk_bf16(v0[0], v0[1]); w.y = cvt_pk_bf16(v0[2], v0[3]); w.z = cvt_pk_bf16(v1[0], v1[1]); w.w = cvt_pk_bf16(v1[2], v1[3]);
                    *(u32x4*)(rowp + bj * 128) = w; } }
    }
};
struct OSched {
    int G, c, nctx; const char* A; const char* B;
    __device__ __forceinline__ bool next(int i, pg8::Unit& u) const {
        const int L = i * G + c;
        if (L < 256) { int pm, pn; pg8::tile_decode(L, 32, 8, pm, pn); pm = ufl(pm); pn = ufl(pn); u.kind = 0; u.nt = 32; u.pm = pm; u.pn = pn; u.a = A + (size_t)pm * MiB; u.b = B + (size_t)pn * MiB; return true; }
        const int s = L - 256; if (s >= nctx) return false;
        const int ch = s & 3, pn = (s >> 2) & 7, pm = 32 + (s >> 5);
        u.kind = 1 + ch; u.nt = 8; u.pm = pm; u.pn = pn; u.a = A + (size_t)pm * MiB + ch * 1024; u.b = B + (size_t)pn * MiB + ch * 1024; return true;
    }
};
struct ResEpi {
    static constexpr bool HAS_MID = false; static constexpr int MID_T = 0;
    bf16_t* out; const void* xin; int in_bf; float* cs_out; const float* gate; int fuse; float* fout; const float* fg; unsigned char* ctl; LAS float* PL;
    __device__ __forceinline__ void operator()(f32x4 (&acc)[2][2][4][2], const pg8::Unit& u, int wr, int wc, int fr, int fq) const {
        if (fuse && u.kind == 0) { asm volatile("" : "+v"(fr), "+v"(fq)); const int pm = u.pm, pn = u.pn; const size_t o = (size_t)pm * 256 * DM + pn * 256;
            pg8::epi_res_final(acc, (const bf16_t*)xin + o, gate + (size_t)(pm >> 3) * 6144 + pn * 256, fout + o, fg + pn * 256, (float*)(ctl + 65536) + (size_t)pm * 256 * 8, (unsigned*)ctl + 4096 + 64 * pm, pn, PL, wr, wc, fr, fq); }
        else (*this)((pg8::AccRef)acc, u, wr, wc, fr, fq);
    }
    bf16_t* out_;
    __device__ __forceinline__ void operator()(pg8::AccRef acc, const pg8::Unit& u, int wr, int wc, int fr, int fq) const {
        asm volatile("" : "+v"(fr), "+v"(fq));
        const int pm = u.pm, pn = u.pn;
        if (u.kind == 0) { const size_t o = (size_t)pm * 256 * DM + pn * 256; const float* gt = gate + (size_t)(pm >> 3) * 6144 + pn * 256;
            if (in_bf) pg8::epi_res<true>(acc, out + o, (const bf16_t*)xin + o, gt, wr, wc, fr, fq); else pg8::epi_res<false>(acc, out + o, (const float*)xin + o, gt, wr, wc, fr, fq); }
        else { float* O = cs_out + (size_t)(u.kind - 1) * MC * DM + (size_t)(pm - 32) * 256 * DM + pn * 256; const float* gt = gate + (size_t)4 * 6144 + pn * 256;
#pragma unroll
            for (int bj = 0; bj < 2; ++bj)
#pragma unroll
                for (int n = 0; n < 2; ++n) { const f32x4 gv = *(const f32x4*)(gt + bj * 128 + wc * 32 + 8 * fq + 4 * n);
#pragma unroll
                    for (int ai = 0; ai < 2; ++ai)
#pragma unroll
                        for (int m = 0; m < 4; ++m) *(f32x4*)(O + (size_t)(ai * 128 + wr * 64 + m * 16 + fr) * DM + bj * 128 + wc * 32 + 8 * fq + 4 * n) = gv * acc[ai][bj][m][n]; }
        }
    }
};

namespace att {
constexpr int D = 128, NW = 8, QBLK = 32, KVBLK = 64;
constexpr float SCALE = 0.088388347648318440f;
constexpr float THR = 8.f;
constexpr int LDQ = 1536, LDK = 512, LDZ = 1536, LDO = 2048;
constexpr size_t SHM_V = KVBLK * D * 2, SHM_K = KVBLK * D * 2, SHM_ATTN = 2 * SHM_V + 2 * SHM_K + NW * 64 * 4;
#define KSWZ(row, colB) ((row) * 256 + ((colB) ^ (((row) & 7) << 4)))
#define SBAR() __builtin_amdgcn_sched_barrier(0)
__device__ __forceinline__ int crow(int r, int hi) { return (r & 3) + 8 * (r >> 2) + 4 * hi; }
__device__ __forceinline__ unsigned cvtpk(float lo, float hi) { unsigned r; asm volatile("v_cvt_pk_bf16_f32 %0, %1, %2" : "=v"(r) : "v"(lo), "v"(hi)); return r; }
__device__ __forceinline__ void partialSM(f32x16& p0, f32x16& p1, float& m_reg, float& mn, float& alpha) {
  constexpr float C = SCALE * 1.4426950408889634f;
  float pmax = p0[0]; for (int r = 1; r < 16; ++r) pmax = fmaxf(pmax, p0[r]); for (int r = 0; r < 16; ++r) pmax = fmaxf(pmax, p1[r]);
  { auto rr = __builtin_amdgcn_permlane32_swap(__float_as_uint(pmax), __float_as_uint(pmax), false, false);
    pmax = fmaxf(__uint_as_float(rr[0]), __uint_as_float(rr[1])); }
  if (__builtin_expect(__all(pmax - m_reg <= THR / SCALE), 1)) { mn = m_reg; alpha = 1.f; }
  else { mn = fmaxf(m_reg, pmax); alpha = __builtin_amdgcn_exp2f((m_reg - mn) * C); m_reg = mn; }
  float mnC = -mn * C;
  for (int r = 0; r < 16; ++r) p0[r] = fmaf(p0[r], C, mnC); for (int r = 0; r < 16; ++r) p1[r] = fmaf(p1[r], C, mnC);
  for (int r = 0; r < 16; ++r) p0[r] = __builtin_amdgcn_exp2f(p0[r]);
}
__device__ __forceinline__ void finishSM(f32x16& p0, f32x16& p1, float alpha, float& l_reg, bf16x8& pa0, bf16x8& pa1, bf16x8& pa2, bf16x8& pa3) {
  for (int r = 0; r < 16; ++r) p1[r] = __builtin_amdgcn_exp2f(p1[r]);
  float ps = 0; for (int r = 0; r < 16; ++r) ps += p0[r]; for (int r = 0; r < 16; ++r) ps += p1[r];
  { auto rr = __builtin_amdgcn_permlane32_swap(__float_as_uint(ps), __float_as_uint(ps), false, false);
    ps = __uint_as_float(rr[0]) + __uint_as_float(rr[1]); }
  l_reg = l_reg * alpha + ps;
#define PK4(P, BASE, OUT) do { unsigned a0 = cvtpk(P[BASE + 0], P[BASE + 1]), a1 = cvtpk(P[BASE + 2], P[BASE + 3]);   \
    unsigned b0 = cvtpk(P[BASE + 4], P[BASE + 5]), b1 = cvtpk(P[BASE + 6], P[BASE + 7]);                              \
    auto r0 = __builtin_amdgcn_permlane32_swap(a0, b0, false, false); auto r1 = __builtin_amdgcn_permlane32_swap(a1, b1, false, false); \
    u32x4 w = {r0[0], r1[0], r0[1], r1[1]}; OUT = *reinterpret_cast<bf16x8*>(&w); } while (0)
  PK4(p0, 0, pa0); PK4(p0, 8, pa1); PK4(p1, 0, pa2); PK4(p1, 8, pa3);
#undef PK4
}
__device__ __forceinline__ void qkt(f32x16& p0, f32x16& p1, const bf16_t* Ks, const bf16x8* qr, int r32, int hi) {
  p0 = f32x16{}; p1 = f32x16{};
  for (int d0 = 0; d0 < 8; ++d0) { int cb = (d0 * 16 + hi * 8) * 2;
    bf16x8 b0 = *reinterpret_cast<const bf16x8*>((const char*)Ks + KSWZ(r32, cb));
    bf16x8 b1 = *reinterpret_cast<const bf16x8*>((const char*)Ks + KSWZ(32 + r32, cb));
    p0 = __builtin_amdgcn_mfma_f32_32x32x16_bf16(b0, qr[d0], p0, 0, 0, 0);
    p1 = __builtin_amdgcn_mfma_f32_32x32x16_bf16(b1, qr[d0], p1, 0, 0, 0); }
}
__device__ __forceinline__ int v_st(int k, int c) { const int kk = (k & ~0xC) | ((k & 4) << 1) | ((k & 8) >> 1); return ((kk >> 3) * 4 + (c >> 5)) * 512 + ((kk & 7) * 32 + (c & 31)) * 2; }
__device__ __forceinline__ int v_rd_base(int lane) { return ((lane & 3) << 3) | (((lane >> 2) & 3) << 6) | (((lane >> 4) & 1) << 5) | (((lane >> 5) & 1) << 8); }
constexpr int v_rd_off(int d0, int ks, int half) { return d0 * 512 + ks * 4096 + half * 2048; }
template <int OFF> __device__ __forceinline__ s16x4 tr_read(int vb) {
  s16x4 r; asm volatile("ds_read_b64_tr_b16 %0, %1 offset:%2" : "=&v"(r) : "v"(vb), "i"(OFF) : "memory"); return r;
}
template <int D0> __device__ __forceinline__ void pv_one(f32x16& od, int vb, bf16x8 pa0, bf16x8 pa1, bf16x8 pa2, bf16x8 pa3) {
  const s16x4 l0 = tr_read<v_rd_off(D0, 0, 0)>(vb), h0 = tr_read<v_rd_off(D0, 0, 1)>(vb), l1 = tr_read<v_rd_off(D0, 1, 0)>(vb), h1 = tr_read<v_rd_off(D0, 1, 1)>(vb);
  const s16x4 l2 = tr_read<v_rd_off(D0, 2, 0)>(vb), h2 = tr_read<v_rd_off(D0, 2, 1)>(vb), l3 = tr_read<v_rd_off(D0, 3, 0)>(vb), h3 = tr_read<v_rd_off(D0, 3, 1)>(vb);
  asm volatile("s_waitcnt lgkmcnt(0)" ::: "memory"); SBAR();
#define PK(L, H) (bf16x8){L[0], L[1], L[2], L[3], H[0], H[1], H[2], H[3]}
  od = __builtin_amdgcn_mfma_f32_32x32x16_bf16(pa0, PK(l0, h0), od, 0, 0, 0);
  od = __builtin_amdgcn_mfma_f32_32x32x16_bf16(pa1, PK(l1, h1), od, 0, 0, 0);
  od = __builtin_amdgcn_mfma_f32_32x32x16_bf16(pa2, PK(l2, h2), od, 0, 0, 0);
  od = __builtin_amdgcn_mfma_f32_32x32x16_bf16(pa3, PK(l3, h3), od, 0, 0, 0);
#undef PK
}
__device__ __forceinline__ void pv_d0(f32x16* o, int vb, bf16x8 pa0, bf16x8 pa1, bf16x8 pa2, bf16x8 pa3) {
  pv_one<0>(o[0], vb, pa0, pa1, pa2, pa3); pv_one<1>(o[1], vb, pa0, pa1, pa2, pa3); pv_one<2>(o[2], vb, pa0, pa1, pa2, pa3); pv_one<3>(o[3], vb, pa0, pa1, pa2, pa3);
}
__device__ __forceinline__ void attn_dense_body(const bf16_t* __restrict__ Qb, const bf16_t* __restrict__ Kh, const bf16_t* __restrict__ Vh,
                                                const bf16_t* __restrict__ ZAb, bf16_t* __restrict__ AAb, int seq, char* lds) {
  int tid = threadIdx.x; asm volatile("" : "+v"(tid));
  const int wid = tid >> 6, lane = tid & 63, r32 = lane & 31, hi = lane >> 5;
  bf16_t* V_lds = (bf16_t*)lds; bf16_t* K_lds = (bf16_t*)(lds + 2 * SHM_V);
  float* ws = (float*)(lds + 2 * SHM_V + 2 * SHM_K) + wid * 64; float* li_l = ws; float* al_l = ws + 32;
  float m_reg = -1e30f, l_reg = 0; f32x16 o[4] = {}; bf16x8 qr[8];
  const bf16_t* Qw = Qb + (long)(wid * QBLK + r32) * LDQ + hi * 8;
#pragma unroll
  for (int d0 = 0; d0 < 8; ++d0) qr[d0] = *reinterpret_cast<const bf16x8*>(Qw + d0 * 16);
  const int sr = tid >> 4, sc = (tid & 15) * 8, vst0 = v_st(sr, sc), vst1 = v_st(32 + sr, sc);
  const int vb0 = (int)(uintptr_t)V_lds + v_rd_base(lane);
  struct { bf16x8 vs0, vs1, ks0, ks1; } sr_[2];
#define SLOAD(i, k0) do { sr_[i].vs0 = *reinterpret_cast<const bf16x8*>(&Vh[(long)((k0) + sr) * LDK + sc]); sr_[i].vs1 = *reinterpret_cast<const bf16x8*>(&Vh[(long)((k0) + 32 + sr) * LDK + sc]); \
    sr_[i].ks0 = *reinterpret_cast<const bf16x8*>(&Kh[(long)((k0) + sr) * LDK + sc]); sr_[i].ks1 = *reinterpret_cast<const bf16x8*>(&Kh[(long)((k0) + 32 + sr) * LDK + sc]); } while (0)
#define SWRITE(b, i) do { *(bf16x8*)((char*)V_lds + (b) * SHM_V + vst0) = sr_[i].vs0;          \
    *(bf16x8*)((char*)V_lds + (b) * SHM_V + vst1) = sr_[i].vs1; int kc = sc * 2;               \
    *(bf16x8*)((char*)K_lds + (b) * SHM_K + KSWZ(sr, kc)) = sr_[i].ks0;                       \
    *(bf16x8*)((char*)K_lds + (b) * SHM_K + KSWZ(32 + sr, kc)) = sr_[i].ks1; } while (0)
#define SWAIT() asm volatile("s_waitcnt vmcnt(4)" ::: "memory")
#define RESC(a) do { if (__any((a) < 1.f)) { if (hi == 0) al_l[r32] = (a); asm volatile("s_waitcnt lgkmcnt(0)" ::: "memory"); \
    for (int d = 0; d < 4; ++d) for (int r = 0; r < 16; ++r) o[d][r] *= al_l[crow(r, hi)]; } } while (0)
  f32x16 pA0, pA1, pB0, pB1; float mnA, mnB, alA, alB; bf16x8 pa0, pa1, pa2, pa3; const int NT = seq / KVBLK;
  constexpr int SE = 0, SO = 1;
  SLOAD(SE, 0); asm volatile("s_waitcnt vmcnt(0)" ::: "memory"); SWRITE(0, SE); __syncthreads();
  qkt(pA0, pA1, K_lds, qr, r32, hi); partialSM(pA0, pA1, m_reg, mnA, alA);
  SLOAD(SO, KVBLK); if (2 < NT) SLOAD(SE, 2 * KVBLK);
  SWAIT(); SWRITE(1, SO); __syncthreads();
  for (int j = 1; j + 1 < NT; j += 2) {
    SBAR(); qkt(pB0, pB1, (bf16_t*)((char*)K_lds + SHM_K), qr, r32, hi);
    finishSM(pA0, pA1, alA, l_reg, pa0, pa1, pa2, pa3); SBAR();
    SLOAD(SO, (j + 2) * KVBLK); SBAR();
    pv_d0(o, vb0, pa0, pa1, pa2, pa3); partialSM(pB0, pB1, m_reg, mnB, alB);
    __syncthreads(); SWAIT(); SWRITE(0, SE);
    RESC(alB); __syncthreads();
    SBAR(); qkt(pA0, pA1, K_lds, qr, r32, hi);
    finishSM(pB0, pB1, alB, l_reg, pa0, pa1, pa2, pa3); SBAR();
    if (j + 3 < NT) SLOAD(SE, (j + 3) * KVBLK); SBAR();
    pv_d0(o, vb0 + (int)SHM_V, pa0, pa1, pa2, pa3); partialSM(pA0, pA1, m_reg, mnA, alA);
    __syncthreads(); SWAIT(); SWRITE(1, SO);
    RESC(alA); __syncthreads();
  }
  SBAR(); qkt(pB0, pB1, (bf16_t*)((char*)K_lds + SHM_K), qr, r32, hi);
  finishSM(pA0, pA1, alA, l_reg, pa0, pa1, pa2, pa3); SBAR();
  pv_d0(o, vb0, pa0, pa1, pa2, pa3); partialSM(pB0, pB1, m_reg, mnB, alB);
  __syncthreads(); RESC(alB);
  finishSM(pB0, pB1, alB, l_reg, pa0, pa1, pa2, pa3); SBAR();
  pv_d0(o, vb0 + (int)SHM_V, pa0, pa1, pa2, pa3);
  if (hi == 0) li_l[r32] = l_reg; asm volatile("s_waitcnt lgkmcnt(0)" ::: "memory");
  float rli[16];
#pragma unroll
  for (int r = 0; r < 16; ++r) rli[r] = __builtin_amdgcn_rcpf(li_l[crow(r, hi)]);
  __syncthreads();
  { char* stg = lds + wid * 8192;
#pragma unroll
    for (int r = 0; r < 16; ++r) { const int orow = crow(r, hi);
#pragma unroll
      for (int d0 = 0; d0 < 4; ++d0) *(bf16_t*)(stg + orow * 256 + (d0 * 32 + r32) * 2) = (bf16_t)(cvtpk(o[d0][r] * rli[r], 0.f) & 0xffffu); }
    asm volatile("s_waitcnt lgkmcnt(0)" ::: "memory");
    int lane_ = lane; asm volatile("" : "+v"(lane_));
    const int rr = lane_ >> 4, ch = lane_ & 15;
#pragma unroll
    for (int i = 0; i < 8; ++i) { const int row = i * 4 + rr; const u32x4 ov = *(const u32x4*)(stg + row * 256 + ch * 16);
      const long gi = (long)(wid * QBLK + row) * LDO + ch * 8; const u32x4 z = *(const u32x4*)(ZAb + (long)(wid * QBLK + row) * LDZ + ch * 8); u32x4 w;
      w.x = cvtpk(bf_lo(ov.x) * bf_lo(z.x), bf_hi(ov.x) * bf_hi(z.x)); w.y = cvtpk(bf_lo(ov.y) * bf_lo(z.y), bf_hi(ov.y) * bf_hi(z.y));
      w.z = cvtpk(bf_lo(ov.z) * bf_lo(z.z), bf_hi(ov.z) * bf_hi(z.z)); w.w = cvtpk(bf_lo(ov.w) * bf_lo(z.w), bf_hi(ov.w) * bf_hi(z.w));
      *(u32x4*)(AAb + gi) = w; } }
#undef SLOAD
#undef SWRITE
#undef SWAIT
#undef RESC
}
#undef KSWZ
#undef SBAR
}


#define XB_TMO      128
#define XB_XCNT(j)  (256  + 64 * (j))
#define XB_XSUB(j)  (1280 + 64 * (j))
#define XB_XGEN(j)  (2304 + 64 * (j))
#define XB_TOP      3328
#define XB_TOPGEN   3392
#define XCD_BAR_WORDS 3456
#define XB_SPIN_CAP (1u << 18)
__device__ __forceinline__ unsigned xb_ld(unsigned* p)              { return __hip_atomic_load(p, __ATOMIC_RELAXED, __HIP_MEMORY_SCOPE_AGENT); }
__device__ __forceinline__ unsigned xb_add(unsigned* p, unsigned v) { return __hip_atomic_fetch_add(p, v, __ATOMIC_RELAXED, __HIP_MEMORY_SCOPE_AGENT); }
__device__ __forceinline__ unsigned xb_xcc_id() { return (unsigned)__builtin_amdgcn_s_getreg((3 << 11) | 20) & 0xFu; }
#define XB_SPIN(cond, bar) do { unsigned _sp = 0; while (cond) { __builtin_amdgcn_s_sleep(1); \
    if ((++_sp & 255u) == 0u) { if (xb_ld(&(bar)[XB_TMO])) break; if (_sp > XB_SPIN_CAP) { atomicAdd(&(bar)[XB_TMO], 1u); break; } } } } while (0)
struct XcdBarrier { unsigned* bar; unsigned x; volatile LAS unsigned* st; };
__device__ __forceinline__ XcdBarrier xcd_barrier_post(unsigned* bar, volatile LAS unsigned* st) {
    XcdBarrier b; b.bar = bar; b.x = xb_xcc_id(); b.st = st;
    if (threadIdx.x == 0) (void)xb_add(&bar[XB_XCNT(b.x)], 1u);
    return b;
}
__device__ __forceinline__ void xcd_barrier_complete(unsigned* bar, unsigned x, unsigned& nloc, unsigned& nx) {
    const unsigned G = gridDim.x * gridDim.y * gridDim.z;
    unsigned sum, cnt, mine, sp = 0u;
    for (;;) {
        sum = 0u; cnt = 0u; mine = 0u;
#pragma unroll
        for (unsigned j = 0; j < 16; ++j) { const unsigned c = xb_ld(&bar[XB_XCNT(j)]); sum += c; cnt += (c > 0u) ? 1u : 0u; mine = (j == x) ? c : mine; }
        if (sum == G) break;
        __builtin_amdgcn_s_sleep(1);
        if ((++sp & 255u) == 0u) { if (xb_ld(&bar[XB_TMO])) break; if (sp > XB_SPIN_CAP) { atomicAdd(&bar[XB_TMO], 1u); break; } }
    }
    nloc = mine > 0u ? mine : 1u; nx = cnt > 0u ? cnt : 1u;
}
__device__ __forceinline__ void xcd_barrier(const XcdBarrier& b) {
    asm volatile("s_waitcnt vmcnt(0)" ::: "memory");
    __syncthreads();
    if (threadIdx.x == 0) {
        unsigned* bar = b.bar;
        __builtin_amdgcn_s_waitcnt(0);
        unsigned nloc = b.st[0], nx = b.st[1];
        if (nloc == 0u) { xcd_barrier_complete(bar, b.x, nloc, nx); b.st[0] = nloc; b.st[1] = nx; }
        const unsigned old = xb_add(&bar[XB_XSUB(b.x)], 1u);
        const unsigned gen = old / nloc;
        if (old + 1u == (gen + 1u) * nloc) {
            __builtin_amdgcn_fence(__ATOMIC_RELEASE, "agent");
            asm volatile("s_waitcnt vmcnt(0)" ::: "memory");
            const unsigned og = xb_add(&bar[XB_TOP], 1u);
            const unsigned tg = og / nx;
            if (og + 1u == (tg + 1u) * nx) xb_add(&bar[XB_TOPGEN], 1u);
            else XB_SPIN(xb_ld(&bar[XB_TOPGEN]) == tg, bar);
            __builtin_amdgcn_fence(__ATOMIC_ACQUIRE, "agent");
            xb_add(&bar[XB_XGEN(b.x)], 1u);
            asm volatile("s_waitcnt vmcnt(0)" ::: "memory");
        } else {
            XB_SPIN(xb_ld(&bar[XB_XGEN(b.x)]) == gen, bar);
            __builtin_amdgcn_fence(__ATOMIC_ACQUIRE, "agent");
            asm volatile("s_waitcnt vmcnt(0)" ::: "memory");
        }
    }
    __syncthreads();
}

struct Args { const float* in[14]; float* out; unsigned char* ws; int ph_lo, ph_hi; };

__device__ __forceinline__ int winT_row(int n) {
    if (n < 2048) { const int hb = n & ~127, d = n & 127, axis = d >> 6, nn = (d >> 5) & 1, f = d & 31; const int wc = axis * 2 + (f >> 4), fq = (f >> 2) & 3, e = f & 3; return hb + wc * 32 + 8 * fq + 4 * nn + e; }
    if (n < 4096) return n;
    return n + 512;
}
template <bool PERMW>
__device__ __forceinline__ void p0_tr_load(const float* W, int N, int kb, int nb, int lane, f32x4 (&v)[8]) {
    const float* src = W + (size_t)(64 * kb + 8 * (lane & 7)) * N + 32 * nb + 4 * (lane >> 3);
#pragma unroll
    for (int e = 0; e < 8; ++e) v[e] = __builtin_nontemporal_load((const f32x4*)(src + (size_t)e * N));
}
template <bool PERMW>
__device__ __forceinline__ void p0_tr_store(bf16_t* WT, int K  , int kb, int nb, int lane, const f32x4 (&v)[8]) {
    const int kq = lane & 7, ng = lane >> 3;
#pragma unroll
    for (int j = 0; j < 4; ++j) { const int n = 32 * nb + 4 * ng + j, row = PERMW ? winT_row(n) : n;
        u32x4 o; o.x = cvt_pk_bf16(v[0][j], v[1][j]); o.y = cvt_pk_bf16(v[2][j], v[3][j]); o.z = cvt_pk_bf16(v[4][j], v[5][j]); o.w = cvt_pk_bf16(v[6][j], v[7][j]);
        *(u32x4*)(WT + (size_t)row * K + 64 * kb + 8 * kq) = o; }
}
struct TrItem { const float* W; bf16_t* WT; int K, N, kb, nb, perm; };
constexpr int TI_IN = 32 * 272, TI_PA = 24 * 64, TI_PB = 8 * 64, TI_O = 32 * 64, TI_L = TI_IN + TI_PA + TI_PB + TI_O;
__device__ __forceinline__ TrItem tr_decode(int it, const float* w_in, const float* w_pa, const float* w_pb, const float* w_out, unsigned char* ws) {
    TrItem t; const int l = it / TI_L; int r = it % TI_L;
    if (r < TI_IN) { const int kb = r / 272, nb0 = r % 272; t.W = w_in + (size_t)l * DM * INW; t.WT = (bf16_t*)(ws + WS_WIN + (size_t)l * 38 * MiB); t.K = DM; t.N = INW; t.kb = kb; t.nb = nb0 < 128 ? nb0 : nb0 + 16; t.perm = 1; return t; }
    r -= TI_IN;
    if (r < TI_PA) { t.W = w_pa + (size_t)l * 1536 * DM; t.WT = (bf16_t*)(ws + WS_WCAT + (size_t)l * 8 * MiB) + 512; t.K = DM; t.N = DM; t.kb = r / 64; t.nb = r % 64; t.perm = 0; return t; }
    r -= TI_PA;
    if (r < TI_PB) { t.W = w_pb + (size_t)l * 512 * DM; t.WT = (bf16_t*)(ws + WS_WCAT + (size_t)l * 8 * MiB); t.K = DM; t.N = DM; t.kb = r / 64; t.nb = r % 64; t.perm = 0; return t; }
    r -= TI_PB;
    t.W = w_out + (size_t)l * DM * DM; t.WT = (bf16_t*)(ws + WS_WO + (size_t)l * 8 * MiB); t.K = DM; t.N = DM; t.kb = r / 64; t.nb = r % 64; t.perm = 0; return t;
}

__global__ void __launch_bounds__(512, 2) mk_fwd(Args args) {
    extern __shared__ __attribute__((aligned(16))) unsigned char lds_raw[];
    LAS unsigned char* lds = (LAS unsigned char*)lds_raw;
    const int tid = threadIdx.x, lane = tid & 63, wave = __builtin_amdgcn_readfirstlane(tid >> 6);
    const int G = gridDim.x, cb = blockIdx.x;
    const int vcu = (G % 8 == 0) ? (cb % 8) * (G / 8) + cb / 8 : cb;
    unsigned char* ws = args.ws;
    const float *x = args.in[0], *cvec = args.in[1], *ctx = args.in[2], *c_ctx = args.in[3], *w_ada = args.in[4], *b_ada = args.in[5], *norm_g = args.in[6], *w_in = args.in[7],
                *q_norm_g = args.in[8], *k_norm_g = args.in[9], *w_pa = args.in[10], *w_pb = args.in[11], *w_out = args.in[12], *final_g = args.in[13];
    float* out = args.out;
    float* MOD = (float*)(ws + WS_MOD); float* ROPE = (float*)(ws + WS_TAB); bf16_t* DM256 = (bf16_t*)(ws + WS_TAB + 65536); bf16_t* DM2K = (bf16_t*)(ws + WS_DM);
    bf16_t *Hb = (bf16_t*)(ws + WS_H), *Qb = (bf16_t*)(ws + WS_Q), *Kb = (bf16_t*)(ws + WS_K), *Vb = (bf16_t*)(ws + WS_V), *ZA = (bf16_t*)(ws + WS_ZA), *ZB = (bf16_t*)(ws + WS_ZB),
           *GA = (bf16_t*)(ws + WS_GA), *GB = (bf16_t*)(ws + WS_GB), *UT = (bf16_t*)(ws + WS_UT), *UTC = (bf16_t*)(ws + WS_UTC), *ACAT = (bf16_t*)(ws + WS_ACAT), *MM = (bf16_t*)(ws + WS_MM);
    bf16_t* XS = (bf16_t*)(ws + WS_XS);
    const int lo = args.ph_lo, hi = args.ph_hi;
#ifndef PHMASK
#define PHMASK 0xffffu
#endif
#define PHON(k) (((PHMASK) >> ((k) > 5 && (k) < 11 ? (k) - 5 : (k))) & 1u)
#define IN(k) (PHON(k) && lo <= (k) && (k) < hi)
#if MK_XCD_BAR
    volatile LAS unsigned* MISC = (volatile LAS unsigned*)(lds + LDS_MISC);
    if (tid < 2) MISC[tid] = 0u;
    __syncthreads();
    XcdBarrier xbar; xbar.bar = (unsigned*)ws; xbar.x = 0; xbar.st = MISC;
    if (hi - lo > 1 && cb == 0) { for (int i = tid; i < 12288; i += 512) ((unsigned*)ws)[i] = 0u; }
#define SEAM(k) do { if (IN(k) && IN((k) + 1)) { if ((k) == 0) { cg::this_grid().sync(); xbar = xcd_barrier_post((unsigned*)ws, MISC); } else xcd_barrier(xbar); } } while (0)
#else
#define SEAM(k) do { if (IN(k) && IN((k) + 1)) { cg::this_grid().sync(); } } while (0)
#endif
    const int gw = vcu * 8 + wave, NGW = G * 8;

    for (int rep = 0; rep < NREP(0); ++rep)
    if (IN(0)) {
        const int tb0 = G == 256 ? 192 : 0, tbn = G - tb0;
        if (cb >= tb0) {
            LAS float* ctab = (LAS float*)lds;
            for (int i = tid; i < 2048; i += 512) ctab[i] = cospif((float)i * (1.f / 1024.f)) * 0.022097086912079608f;
            __syncthreads();
            for (int idx8 = (cb - tb0) * 512 + tid; idx8 < 2048 * 512; idx8 += tbn * 512) { const int n = idx8 >> 9, j0 = (idx8 & 511) * 8; float v[8];
#pragma unroll
                for (int e = 0; e < 8; ++e) { const int j = j0 + e; v[e] = j < 2048 ? ctab[(n * j) & 2047] : -ctab[(n * (j - 2048) - 512) & 2047]; }
                u32x4 o; o.x = cvt_pk_bf16(v[0], v[1]); o.y = cvt_pk_bf16(v[2], v[3]); o.z = cvt_pk_bf16(v[4], v[5]); o.w = cvt_pk_bf16(v[6], v[7]);
                *(u32x4*)(DM2K + (size_t)n * 4096 + j0) = o; }
            for (int idx8 = (cb - tb0) * 512 + tid; idx8 < 256 * 64; idx8 += tbn * 512) { const int n = idx8 >> 6, j0 = (idx8 & 63) * 8; float v[8];
#pragma unroll
                for (int e = 0; e < 8; ++e) { const int j = j0 + e; v[e] = 2.8284271247461903f * (j < 256 ? ctab[((n * j) & 255) * 8] : -ctab[((((n * (j - 256)) & 255) * 8) - 512) & 2047]); }
                u32x4 o; o.x = cvt_pk_bf16(v[0], v[1]); o.y = cvt_pk_bf16(v[2], v[3]); o.z = cvt_pk_bf16(v[4], v[5]); o.w = cvt_pk_bf16(v[6], v[7]);
                *(u32x4*)(DM256 + (size_t)n * 512 + j0) = o; }
            for (int idx = (cb - tb0) * 512 + tid; idx < 64 * 32; idx += tbn * 512) { const int pos = idx >> 5, f = idx & 31; const float inv = exp2f(-(float)f * (13.287712379549449f / 32.f)); const float ang = (float)pos * inv;
                ROPE[idx * 2] = cosf(ang); ROPE[idx * 2 + 1] = sinf(ang); }
            for (int idx8 = (cb - tb0) * 512 + tid; idx8 < 256 * 16; idx8 += tbn * 512) { const int jp = idx8 >> 4, c0 = (idx8 & 15) * 8, cp = jp & 127; float v[8];
#pragma unroll
                for (int e = 0; e < 8; ++e) { const float ph = (float)(((c0 + e) * cp) & 127) * (1.f / 64.f); v[e] = (jp < 128 ? cospif(ph) : sinpif(ph)) * 0.08838834764831845f; }
                u32x4 o; o.x = cvt_pk_bf16(v[0], v[1]); o.y = cvt_pk_bf16(v[2], v[3]); o.z = cvt_pk_bf16(v[4], v[5]); o.w = cvt_pk_bf16(v[6], v[7]);
                *(u32x4*)((bf16_t*)(ws + WS_TT) + jp * 128 + c0) = o; }
            __syncthreads();
        }
        {
            LAS float* sc = (LAS float*)lds;
            LAS float* part = (LAS float*)(lds + 40960);
            for (int idx = tid; idx < 5 * 2048; idx += 512) { const int r = idx >> 11, k = idx & 2047; const float v = r < 4 ? cvec[r * 2048 + k] : c_ctx[k]; sc[idx] = v * sigmoidf_(v); }
            __syncthreads();
            for (int item = cb; item < 192; item += G) {
                const int l = item / 96, cc = item % 96, cg4 = lane & 15, kp = lane >> 4;
                const float* wp = w_ada + ((size_t)l * 2048 + wave * 256 + kp) * 6144 + cc * 64 + cg4 * 4;
                f32x4 a0 = {0.f, 0.f, 0.f, 0.f}, a1 = a0, a2 = a0, a3 = a0, a4 = a0;
#pragma unroll 8
                for (int i = 0; i < 64; ++i) { const f32x4 w = *(const f32x4*)(wp + (size_t)i * 4 * 6144); const int k = wave * 256 + 4 * i + kp;
                    a0 += w * sc[k]; a1 += w * sc[2048 + k]; a2 += w * sc[4096 + k]; a3 += w * sc[6144 + k]; a4 += w * sc[8192 + k]; }
#pragma unroll
                for (int e = 0; e < 4; ++e) { a0[e] += __shfl_xor(a0[e], 16); a0[e] += __shfl_xor(a0[e], 32); a1[e] += __shfl_xor(a1[e], 16); a1[e] += __shfl_xor(a1[e], 32);
                    a2[e] += __shfl_xor(a2[e], 16); a2[e] += __shfl_xor(a2[e], 32); a3[e] += __shfl_xor(a3[e], 16); a3[e] += __shfl_xor(a3[e], 32); a4[e] += __shfl_xor(a4[e], 16); a4[e] += __shfl_xor(a4[e], 32); }
                if (kp == 0) { LAS float* pp = part + wave * 320 + cg4 * 4;
                    *(LAS f32x4*)(pp) = a0; *(LAS f32x4*)(pp + 64) = a1; *(LAS f32x4*)(pp + 128) = a2; *(LAS f32x4*)(pp + 192) = a3; *(LAS f32x4*)(pp + 256) = a4; }
                __syncthreads();
                if (tid < 320) { const int r = tid >> 6, j = tid & 63; float s = b_ada[l * 6144 + cc * 64 + j];
#pragma unroll
                    for (int w = 0; w < 8; ++w) s += part[w * 320 + r * 64 + j];
                    MOD[((size_t)l * 5 + r) * 6144 + cc * 64 + j] = s; }
                __syncthreads();
            }
            __syncthreads();
        }
        {
            for (int it = gw; it < 2 * TI_L; it += 2 * NGW) {
                const TrItem t0 = tr_decode(it, w_in, w_pa, w_pb, w_out, ws); const bool two = it + NGW < 2 * TI_L;
                const TrItem t1 = tr_decode(two ? it + NGW : it, w_in, w_pa, w_pb, w_out, ws);
                f32x4 v0[8], v1[8];
                p0_tr_load<false>(t0.W, t0.N, t0.kb, t0.nb, lane, v0);
                if (two) p0_tr_load<false>(t1.W, t1.N, t1.kb, t1.nb, lane, v1);
                if (t0.perm) p0_tr_store<true>(t0.WT, t0.K, t0.kb, t0.nb, lane, v0); else p0_tr_store<false>(t0.WT, t0.K, t0.kb, t0.nb, lane, v0);
                if (two) { if (t1.perm) p0_tr_store<true>(t1.WT, t1.K, t1.kb, t1.nb, lane, v1); else p0_tr_store<false>(t1.WT, t1.K, t1.kb, t1.nb, lane, v1); }
            }
            __syncthreads();
        }
        {
            bf16_t* WUB = (bf16_t*)(ws + WS_WUB);
            for (int idx8 = cb * 512 + tid; idx8 < 2 * 4 * 2048 * 16; idx8 += G * 512) { const int e = idx8 * 8, c0 = e & 127, k = (e >> 7) & 2047, g = (e >> 18) & 3, l2 = e >> 20;
                const float* src = w_in + ((size_t)l2 * DM + k) * INW + 4096 + g * 128 + c0; const f32x4 a = *(const f32x4*)src, b = *(const f32x4*)(src + 4);
                u32x4 o; o.x = cvt_pk_bf16(a[0], a[1]); o.y = cvt_pk_bf16(a[2], a[3]); o.z = cvt_pk_bf16(b[0], b[1]); o.w = cvt_pk_bf16(b[2], b[3]);
                *(u32x4*)(WUB + e) = o; }
        }
    }
    SEAM(0);

    const bool handoff = (G == 256 && hi - lo > 1);
    const bool fuse_final = (G == 256 && hi - lo > 1);
    for (int l = 0; l < 2; ++l) {
        const int P = 1 + 5 * l;
        const float* modl = MOD + (size_t)l * 5 * 6144;
        const int nM = l == 0 ? 36 : 32;
        for (int rep = 0; rep < NREP(P + 0); ++rep)
        if (IN(P)) {
            int lane = tid & 63; asm volatile("" : "+v"(lane));
            const float* xs = x; const float* cs = ctx; const float* PART = (const float*)(ws + WS_PART); const float* gn = norm_g + l * DM;
            const bool foldcu = (l == 0 && G == 256);
            const int r0 = foldcu ? (vcu >= 64 ? (vcu - 64) * 8 + wave : MT) : gw, rstep = foldcu ? 192 * 8 : NGW;
            const bool nbal = (l == 1 && G == 256);
            const int kmax = nbal ? 5 : (r0 < MT ? (MT - r0 + rstep - 1) / rstep : 0);
            for (int k = 0; k < kmax; ++k) {
                int r;
                if (nbal) { if (gw < 1024) { if (k == 4) continue; r = k == 0 ? ML + gw : gw + (k - 1) * 1024; } else r = 3072 + (gw - 1024) + k * 1024; }
                else r = r0 + k * rstep;
                const float* src = r < ML ? xs + (size_t)r * DM : cs + (size_t)(r - ML) * DM;
                const float* mrow = modl + (size_t)(r < ML ? (r >> 11) : 4) * 6144;
                f32x4 v[8]; float ss = 0.f;
#pragma unroll
                for (int j = 0; j < 8; ++j) v[j] = (f32x4){0.f, 0.f, 0.f, 0.f};
                if (!(l == 1 && r < ML)) {
#pragma unroll
                    for (int j = 0; j < 8; ++j) v[j] = *(const f32x4*)(src + j * 256 + lane * 4); }
                else {
#pragma unroll
                    for (int j = 0; j < 8; ++j) { const u32x2 q = *(const u32x2*)(XS + (size_t)r * DM + j * 256 + lane * 4); v[j] = (f32x4){bf_lo(q.x), bf_hi(q.x), bf_lo(q.y), bf_hi(q.y)}; } }
                if (l == 1 && r >= ML) {
                    const float* pp = PART + (size_t)(r - ML) * DM + lane * 4;
#pragma unroll
                    for (int ch = 0; ch < 4; ++ch)
#pragma unroll
                        for (int j = 0; j < 8; ++j) v[j] += *(const f32x4*)(pp + (size_t)ch * MC * DM + j * 256); }
#pragma unroll
                for (int j = 0; j < 8; ++j) ss += (v[j][0] * v[j][0] + v[j][1] * v[j][1]) + (v[j][2] * v[j][2] + v[j][3] * v[j][3]);
                const float rstd = __builtin_amdgcn_rsqf(wave_sum(ss) * (1.f / DM) + EPS);
#pragma unroll
                for (int j = 0; j < 8; ++j) { const int col = j * 256 + lane * 4; const f32x4 g = *(const f32x4*)(gn + col), sh = *(const f32x4*)(mrow + col), sl = *(const f32x4*)(mrow + 2048 + col);
                    const f32x4 h = (v[j] * rstd * g) * (sl + 1.f) + sh; u32x2 w; w.x = cvt_pk_bf16(h[0], h[1]); w.y = cvt_pk_bf16(h[2], h[3]);
                    *(u32x2*)(Hb + (size_t)r * DM + col) = w; }
            }
            if (l == 0) {
                __syncthreads();
                FoldSched S; S.G = G; S.c = vcu; S.Tt = (const char*)(ws + WS_TT); S.Wub = (const char*)(ws + WS_WUB);
                FoldEpi E; E.ws = ws; pg8::gemm_phase(lds, 128, S, E);
            }
        }
        SEAM(P);
        for (int rep = 0; rep < NREP(P + 1); ++rep)
        if (IN(P + 1)) {
            G1Sched S; S.Gq = G; S.cq = cb; S.nM = nM; S.nA = nM * 18; S.n1 = 4 * nM; S.n2 = l == 0 ? 0 : 16; S.Lbase = 0;
            S.split = (l == 0 && G == 256) ? 1 : 0;
            { const int tot = S.nA + S.n1 + S.n2 + nM * 16; S.Lend = (l == 0 && G == 256) ? 1280 : tot; }
            S.H = (const char*)Hb; S.W = (const char*)(ws + WS_WIN + (size_t)l * 38 * MiB);
            G1Epi E; E.ws = ws; E.qg = q_norm_g + l * 128; E.kg = k_norm_g + l * 128; E.X = (LAS float*)(lds + LDS_X);
            pg8::gemm_phase(lds, DM, S, E);
        }
        SEAM(P + 1);
        for (int rep = 0; rep < NREP(P + 2); ++rep)
        if (IN(P + 2)) {
            const int nun = l == 0 ? 384 + 48 : 384;
#ifndef NO_ATT
            const int astride = (l == 1 && G == 256) ? 192 : G;
            const bool ctxm1 = (l == 0 && G == 256 && hi - lo > 1);
            const int nk = ctxm1 ? 3 : (nun + astride - 1) / astride + 1;
            for (int k = 0; k < nk; ++k) {
                int a;
                if (ctxm1) a = (k == 0) ? (vcu < 48 ? 384 + vcu : -1) : (vcu + (k - 1) * 256 < 384 ? vcu + (k - 1) * 256 : -1);
                else { a = vcu < astride ? vcu + k * astride : -1; if (a >= nun) a = -1; }
                if (a < 0) continue;
                __syncthreads();
                size_t qo, ko, ao; int seq;
                if (a < 384) { const int bk = a / 24, hq = (a % 24) >> 3, qb = a & 7, b = bk >> 2, kvh = bk & 3, h = kvh * 3 + hq;
                    qo = ((size_t)b * SEQ + qb * 256) * 1536 + h * 128; ao = ((size_t)b * SEQ + qb * 256) * DM + 512 + h * 128; ko = (size_t)b * KEYS * 512 + kvh * 128; seq = KEYS;
                } else { const int a2 = a - 384, b = a2 / 12, h = a2 % 12, kvh = h / 3;
                    qo = ((size_t)ML + b * CTX) * 1536 + h * 128; ao = ((size_t)ML + b * CTX) * DM + 512 + h * 128; ko = ((size_t)b * KEYS + SEQ) * 512 + kvh * 128; seq = CTX; }
                qo = ufl64(qo); ko = ufl64(ko); ao = ufl64(ao); seq = ufl(seq);
                att::attn_dense_body(Qb + qo, Kb + ko, Vb + ko, ZA + qo, ACAT + ao, seq, (char*)lds_raw);
                if (ctxm1 && a >= 384) {
                    asm volatile("s_waitcnt vmcnt(0)" ::: "memory"); __syncthreads();
                    if (tid == 0) { __builtin_amdgcn_fence(__ATOMIC_RELEASE, "agent"); asm volatile("s_waitcnt vmcnt(0)" ::: "memory");
                        (void)__hip_atomic_fetch_add((unsigned*)ws + CW_CTXCNT, 1u, __ATOMIC_RELAXED, __HIP_MEMORY_SCOPE_AGENT); }
                }
            }
#endif
            __syncthreads();
#ifndef NO_FN
            { FnSched S; S.G = G; S.c = vcu; S.cu0 = G >= 256 ? 192 : 0; S.nunits = 64; S.ntn = 8; S.nt = 64; S.A = (const char*)DM2K; S.B = (const char*)UT; S.astep = 2 * MiB; S.bstep = 2 * MiB; S.bbatch = 4 * MiB; S.row_base = 0; S.rows_per_b = SEQ;
              FnEpi E; E.ACAT = ACAT; E.ZB = ZB; pg8::gemm_phase(lds, 4096, S, E); }
            if (l == 0) { FnSched S; S.G = G; S.c = vcu; S.cu0 = G >= 256 ? 176 : 0; S.nunits = 8; S.ntn = 1; S.nt = 8; S.A = (const char*)DM256; S.B = (const char*)UTC; S.astep = 0; S.bstep = MiB / 4; S.bbatch = MiB / 2; S.row_base = ML; S.rows_per_b = CTX;
              FnEpi E; E.ACAT = ACAT; E.ZB = ZB; pg8::gemm_phase(lds, 512, S, E); }
#endif
            if (ctxm1 && vcu >= 176 && vcu < 184) {
                asm volatile("s_waitcnt vmcnt(0)" ::: "memory"); __syncthreads();
                if (tid == 0) { __builtin_amdgcn_fence(__ATOMIC_RELEASE, "agent"); asm volatile("s_waitcnt vmcnt(0)" ::: "memory");
                    (void)__hip_atomic_fetch_add((unsigned*)ws + CW_CTXCNT, 1u, __ATOMIC_RELAXED, __HIP_MEMORY_SCOPE_AGENT); }
            }
            if (l == 0 && G == 256) {
                G1Sched S; S.Gq = 64; S.cq = (vcu >= 160 && vcu < 176) ? vcu - 160 : (vcu >= 184 && vcu < 192) ? 16 + vcu - 184 : (vcu >= 128 && vcu < 160) ? 24 + vcu - 128 : (vcu >= 176 && vcu < 184) ? 56 + vcu - 176 : -1; S.nM = nM; S.nA = nM * 18; S.n1 = 4 * nM; S.n2 = 0; S.Lbase = 1280; S.Lend = S.nA + S.n1 + nM * 16; S.split = 1;
                S.H = (const char*)Hb; S.W = (const char*)(ws + WS_WIN);
                G1Epi E; E.ws = ws; E.qg = q_norm_g; E.kg = k_norm_g; E.X = (LAS float*)(lds + LDS_X);
                pg8::gemm_phase(lds, DM, S, E);
            }
            if (ctxm1 && vcu >= 128 && vcu < 160) {
                if (tid == 0) { unsigned sp = 0;
                    while (__hip_atomic_load((unsigned*)ws + CW_CTXCNT, __ATOMIC_RELAXED, __HIP_MEMORY_SCOPE_AGENT) < 56u) { __builtin_amdgcn_s_sleep(2); if (++sp > (1u << 22)) break; }
                    __builtin_amdgcn_fence(__ATOMIC_ACQUIRE, "agent"); asm volatile("s_waitcnt vmcnt(0)" ::: "memory"); }
                __syncthreads();
                CtxM1Sched S; S.cq = vcu - 128; S.A = (const char*)ACAT; S.B = (const char*)(ws + WS_WCAT);
                M1Epi E; E.MMo = MM; E.GA = GA; E.GB = GB; pg8::gemm_phase(lds, DM, S, E);
            }
        }
        SEAM(P + 2);
        for (int rep = 0; rep < NREP(P + 3); ++rep)
        if (IN(P + 3)) {
            M1Sched S; S.G = G; S.c = cb; S.nM = (l == 0 && G == 256 && hi - lo > 1) ? 32 : nM; S.A = (const char*)ACAT; S.B = (const char*)(ws + WS_WCAT + (size_t)l * 8 * MiB);
            M1Epi E; E.MMo = MM; E.GA = GA; E.GB = GB; pg8::gemm_phase(lds, DM, S, E);
            if (handoff) {
                int pm_, pn_; pg8::tile_decode(cb, 32, 8, pm_, pn_); pm_ = ufl(pm_);
                asm volatile("s_waitcnt vmcnt(0)" ::: "memory"); __syncthreads();
                if (tid == 0) { __builtin_amdgcn_fence(__ATOMIC_RELEASE, "agent"); asm volatile("s_waitcnt vmcnt(0)" ::: "memory");
                    (void)__hip_atomic_fetch_add((unsigned*)ws + 6144 + 64 * (l * 32 + pm_), 1u, __ATOMIC_RELAXED, __HIP_MEMORY_SCOPE_AGENT); }
            }
        }
        if (!handoff) SEAM(P + 3);
        for (int rep = 0; rep < NREP(P + 4); ++rep)
        if (IN(P + 4)) {
            if (handoff) {
                int pm_, pn_; pg8::tile_decode(cb, 32, 8, pm_, pn_); pm_ = ufl(pm_);
                if (tid == 0) { unsigned sp = 0;
                    while (__hip_atomic_load((unsigned*)ws + 6144 + 64 * (l * 32 + pm_), __ATOMIC_RELAXED, __HIP_MEMORY_SCOPE_AGENT) < 8u) { __builtin_amdgcn_s_sleep(1); if (++sp > (1u << 22)) break; }
                    __builtin_amdgcn_fence(__ATOMIC_ACQUIRE, "agent"); asm volatile("s_waitcnt vmcnt(0)" ::: "memory"); }
                __syncthreads();
            }
            OSched S; S.G = G; S.c = cb; S.nctx = l == 0 ? 128 : 0; S.A = (const char*)MM; S.B = (const char*)(ws + WS_WO + (size_t)l * 8 * MiB);
            ResEpi E; E.out = XS; E.xin = l == 0 ? (const void*)x : (const void*)XS; E.in_bf = l; E.cs_out = (float*)(ws + WS_PART); E.gate = modl + 4096; E.fuse = (l == 1 && fuse_final) ? 1 : 0; E.fout = out; E.fg = final_g; E.ctl = ws; E.PL = (LAS float*)(lds + LDS_X); pg8::gemm_phase(lds, DM, S, E);
        }
        if (!(l == 1 && fuse_final)) SEAM(P + 4);
    }
    if (IN(11) && !fuse_final) {
        for (int r = gw; r < ML; r += NGW) {
            float* src = out + (size_t)r * DM; f32x4 v[8]; float ss = 0.f;
#pragma unroll
            for (int j = 0; j < 8; ++j) { const u32x2 q = *(const u32x2*)(XS + (size_t)r * DM + j * 256 + lane * 4); v[j] = (f32x4){bf_lo(q.x), bf_hi(q.x), bf_lo(q.y), bf_hi(q.y)};
                ss += (v[j][0] * v[j][0] + v[j][1] * v[j][1]) + (v[j][2] * v[j][2] + v[j][3] * v[j][3]); }
            const float rstd = __builtin_amdgcn_rsqf(wave_sum(ss) * (1.f / DM) + EPS);
#pragma unroll
            for (int j = 0; j < 8; ++j) { const int col = j * 256 + lane * 4; const f32x4 g = *(const f32x4*)(final_g + col); f32x4 o = v[j] * rstd * g;
                *(f32x4*)(src + col) = o; }
        }
    }
#undef IN
#undef SEAM
}

extern "C" void kernel_launch(void* const* d_in, const int* in_sizes, int n_in, void* d_out, int out_size, void* d_ws, size_t ws_size, hipStream_t stream) {
    static int grid = 0;
    if (grid == 0) {
        if (n_in != 14 || in_sizes[0] != ML * DM || out_size != ML * DM || ws_size < WS_END) { fprintf(stderr, "kernel_launch: unexpected shapes (n_in %d, in0 %d, out %d, ws %zu < %zu)\n", n_in, n_in > 0 ? in_sizes[0] : -1, out_size, ws_size, (size_t)WS_END); grid = -1; return; }
        int dev = 0, cus = 0, per_cu = 0;
        hipGetDevice(&dev); hipDeviceGetAttribute(&cus, hipDeviceAttributeMultiprocessorCount, dev);
        if (hipFuncSetAttribute((const void*)mk_fwd, hipFuncAttributeMaxDynamicSharedMemorySize, LDS_BYTES) != hipSuccess) { fprintf(stderr, "kernel_launch: hipFuncSetAttribute failed\n"); grid = -1; return; }
        if (hipOccupancyMaxActiveBlocksPerMultiprocessor(&per_cu, (const void*)mk_fwd, 512, LDS_BYTES) != hipSuccess || per_cu < 1) { fprintf(stderr, "kernel_launch: occupancy query says %d\n", per_cu); per_cu = 1; }
        (void)hipGetLastError();
        grid = cus > 0 ? cus : 256;
    }
    if (grid < 0) return;
    Args a{};
    for (int i = 0; i < 14; ++i) a.in[i] = (const float*)d_in[i];
    a.out = (float*)d_out; a.ws = (unsigned char*)d_ws;
#if MK_ONE_LAUNCH
    a.ph_lo = 0; a.ph_hi = NPH;
    void* kargs[] = {&a};
    hipError_t e = hipLaunchCooperativeKernel((const void*)mk_fwd, dim3(grid), dim3(512), kargs, LDS_BYTES, stream);
    if (e != hipSuccess) fprintf(stderr, "kernel_launch: cooperative launch failed: %s (grid %d)\n", hipGetErrorString(e), grid);
#else
    for (int p = 0; p < NPH; ++p) {
        a.ph_lo = p; a.ph_hi = p + 1;
        hipLaunchKernelGGL(mk_fwd, dim3(grid), dim3(512), LDS_BYTES, stream, a);
    }
    hipError_t e = hipPeekAtLastError();
    if (e != hipSuccess) fprintf(stderr, "kernel_launch: launch failed: %s\n", hipGetErrorName(e));
#endif
}
```

```cpp
#include <hip/hip_runtime.h>
#include <hip/hip_cooperative_groups.h>
#include <cstdio>
#include <cstdint>
namespace cg = cooperative_groups;

#ifndef MK_ONE_LAUNCH
#define MK_ONE_LAUNCH 1
#endif
#ifndef MK_XCD_BAR
#define MK_XCD_BAR 1
#endif
#ifndef PROBE_REP
#define PROBE_REP (-1)
#endif
#define NREP(k) ((k) == PROBE_REP ? 2 : 1)


#define LAS __attribute__((address_space(3)))
typedef unsigned short bf16_t;
typedef short bf16x8 __attribute__((ext_vector_type(8)));
typedef short s16x4 __attribute__((ext_vector_type(4)));
typedef float f32x4 __attribute__((ext_vector_type(4)));
typedef float f32x16 __attribute__((ext_vector_type(16)));
typedef unsigned u32x4 __attribute__((ext_vector_type(4)));
typedef unsigned u32x2 __attribute__((ext_vector_type(2)));

constexpr int DM = 2048, NB = 4, SEQ = 2048, CTX = 256;
constexpr int ML = NB * SEQ, MC = NB * CTX, MT = ML + MC;
constexpr int INW = 9216, KEYS = SEQ + CTX;
constexpr int NPH = 12;
constexpr float EPS = 1e-6f;

constexpr size_t MiB = 1u << 20;
constexpr size_t WS_MOD = 1 * MiB;
constexpr size_t WS_TAB = 2 * MiB;
constexpr size_t WS_TT = 2 * MiB + 512 * 1024;
constexpr size_t WS_DM = 3 * MiB;
constexpr size_t WS_WIN = 19 * MiB;
constexpr size_t WS_WCAT = 95 * MiB;
constexpr size_t WS_WO = 111 * MiB;
constexpr size_t WS_H = 127 * MiB;
constexpr size_t WS_Q = 163 * MiB;
constexpr size_t WS_K = 190 * MiB;
constexpr size_t WS_V = 199 * MiB;
constexpr size_t WS_ZA = 208 * MiB;
constexpr size_t WS_ZB = 235 * MiB;
constexpr size_t WS_GA = 244 * MiB;
constexpr size_t WS_GB = 280 * MiB;
constexpr size_t WS_UT = 316 * MiB;
constexpr size_t WS_UTC = 332 * MiB;
constexpr size_t WS_WUB = 334 * MiB;
constexpr size_t WS_XS = 338 * MiB;
constexpr size_t WS_AA = 338 * MiB;
constexpr size_t WS_AB = 361 * MiB;
constexpr size_t WS_ACAT = 370 * MiB;
constexpr size_t WS_MM = 406 * MiB;
constexpr size_t WS_CS1 = 442 * MiB;
constexpr size_t WS_PART = 450 * MiB;
constexpr size_t WS_END = 514 * MiB;

constexpr int LDS_BYTES = 147456;
constexpr int LDS_X = 131072;
constexpr int LDS_MISC = 131072 + 8192;
constexpr int CW_CTXCNT = 3520;
constexpr size_t CTL_ZERO_BYTES = 16384;

__device__ __forceinline__ unsigned cvt_pk_bf16(float lo, float hi) { unsigned r; asm volatile("v_cvt_pk_bf16_f32 %0, %1, %2" : "=v"(r) : "v"(lo), "v"(hi)); return r; }
__device__ __forceinline__ float bf_lo(unsigned w) { return __uint_as_float(w << 16); }
__device__ __forceinline__ float bf_hi(unsigned w) { return __uint_as_float(w & 0xffff0000u); }
__device__ __forceinline__ float bf2f(bf16_t v) { return __uint_as_float((unsigned)v << 16); }
__device__ __forceinline__ unsigned f2bf(float f) { unsigned u = __builtin_bit_cast(unsigned, f); return (u + 0x7fffu + ((u >> 16) & 1u)) >> 16; }
__device__ __forceinline__ float sigmoidf_(float x) { return __builtin_amdgcn_rcpf(1.f + __builtin_amdgcn_exp2f(-1.4426950408889634f * x)); }
__device__ __forceinline__ int ufl(int v) { return __builtin_amdgcn_readfirstlane(v); }
__device__ __forceinline__ size_t ufl64(size_t v) { const unsigned lo = __builtin_amdgcn_readfirstlane((unsigned)v), hi = __builtin_amdgcn_readfirstlane((unsigned)(v >> 32)); return ((size_t)hi << 32) | lo; }
__device__ __forceinline__ float wave_sum(float v) {
#pragma unroll
    for (int o = 1; o < 64; o <<= 1) v += __shfl_xor(v, o);
    return v;
}

namespace pg8 {
constexpr int BM = 256, BK = 64, HALF = 128, HTB = HALF * BK * 2, STAGE_BYTES = 8 * HTB;
__host__ __device__ __forceinline__ int lds_byte(int r, int c) { const int st = (r >> 4) * 2 + (c >> 5), rr = r & 15, cc = c & 31, ob = rr * 64 + cc * 2; return st * 1024 + (ob ^ (((ob >> 9) & 1) << 5)); }
__host__ __device__ __forceinline__ void stage_rc(int b, int& R, int& C) { const int st = b / 1024, sb = b % 1024, swz = sb ^ (((sb >> 9) & 1) << 5); R = (st >> 1) * 16 + swz / 64; C = (st & 1) * 32 + (swz % 64) / 2; }
__host__ __device__ __forceinline__ int perm32(int rho) { const int n = rho >> 4, i = rho & 15; return 8 * (i >> 2) + 4 * n + (i & 3); }

struct Unit { int kind, pm, pn, nt, keep; const char* a; const char* b; };

__device__ __forceinline__ void tile_decode(int L, int nM, int nN, int& pm, int& pn) {
    const int nwg = nM * nN; int wgid = L;
    { const int q = nwg / 8, r = nwg % 8, xcd = wgid % 8, off = wgid / 8; wgid = (xcd < r ? xcd * (q + 1) : r * (q + 1) + (xcd - r) * q) + off; }
    const int nig = 8 * nN, gid = wgid / nig, fm = gid * 8, gsz = (nM - fm) < 8 ? (nM - fm) : 8;
    pm = fm + ((wgid % nig) % gsz); pn = (wgid % nig) / gsz;
}

template <class Epi, class Sched>
__device__ __forceinline__ void gemm_phase(LAS unsigned char* lds, const int K, const Sched& S, const Epi& E) {
    int tid = threadIdx.x; asm volatile("" : "+v"(tid));
    const int wid = __builtin_amdgcn_readfirstlane(tid >> 6), lane = tid & 63, wr = wid >> 2, wc = wid & 3, fr = lane & 15, fq = lane >> 4;
    unsigned voffA[2], voffB[2];
#pragma unroll
    for (int i = 0; i < 2; ++i) { int R, C; stage_rc(tid * 16 + i * 8192, R, C); const int Rb = (R & ~31) + perm32(R & 31);
        voffA[i] = (unsigned)(R * K + C) * 2u; voffB[i] = (unsigned)(Rb * K + C) * 2u; }
    const size_t kstep = (size_t)(BK * 2);
    const size_t hstep = (size_t)HALF * K * 2;
    const unsigned ldsw = (unsigned)wid * 1024u;
    const int aoff = lds_byte(wr * 64 + fr, fq * 8), boff = lds_byte(wc * 32 + fr, fq * 8);
#define PG8_SA(b, h) (((b) * 2 + (h)) * HTB)
#define PG8_SB(b, h) ((4 + (b) * 2 + (h)) * HTB)
#define PG8_STAGE(bufoff, gbase, voff) do { _Pragma("unroll") for (int _i = 0; _i < 2; ++_i) \
        __builtin_amdgcn_global_load_lds((const unsigned*)((const char*)(gbase) + (voff)[_i]), (LAS unsigned*)(lds + (bufoff) + ldsw + _i * 8192), 16, 0, 0); } while (0)
#define PG8_LDA(dst, b, h) do { _Pragma("unroll") for (int m = 0; m < 4; ++m) _Pragma("unroll") for (int k = 0; k < 2; ++k) dst[m][k] = *(const LAS bf16x8*)(lds + PG8_SA(b, h) + aoff + m * 2048 + k * 1024); } while (0)
#define PG8_LDB(dst, b, h) do { _Pragma("unroll") for (int n = 0; n < 2; ++n) _Pragma("unroll") for (int k = 0; k < 2; ++k) dst[n][k] = *(const LAS bf16x8*)(lds + PG8_SB(b, h) + boff + n * 2048 + k * 1024); } while (0)
#define PG8_MMA(ai, bj, At, Bt) do { __builtin_amdgcn_s_setprio(1); _Pragma("unroll") for (int m = 0; m < 4; ++m) _Pragma("unroll") for (int n = 0; n < 2; ++n) _Pragma("unroll") for (int k = 0; k < 2; ++k) \
        acc[ai][bj][m][n] = __builtin_amdgcn_mfma_f32_16x16x32_bf16(Bt[n][k], At[m][k], acc[ai][bj][m][n], 0, 0, 0); __builtin_amdgcn_s_setprio(0); } while (0)
#define PG8_WAIT_V(n) asm volatile("s_waitcnt vmcnt(" #n ")" ::: "memory")
#define PG8_WAIT_L(n) asm volatile("s_waitcnt lgkmcnt(" #n ")" ::: "memory")
#define PG8_BAR __builtin_amdgcn_s_barrier()
#define PG8_SCHED __builtin_amdgcn_sched_barrier(0)
    Unit cur, nxt; int ui = 0; cur.keep = 0;
    if (!S.next(0, cur)) return;
    f32x4 acc[2][2][4][2];
#pragma unroll
    for (int a = 0; a < 2; ++a)
#pragma unroll
        for (int b = 0; b < 2; ++b)
#pragma unroll
            for (int m = 0; m < 4; ++m)
#pragma unroll
                for (int n = 0; n < 2; ++n) acc[a][b][m][n] = (f32x4){0.f, 0.f, 0.f, 0.f};
    bf16x8 At[4][2], B0[2][2], B1[2][2];
    const char* cA = cur.a; const char* cB = cur.b;
    PG8_STAGE(PG8_SB(0, 0), cB, voffB); PG8_STAGE(PG8_SB(0, 1), cB + hstep, voffB); PG8_STAGE(PG8_SA(0, 0), cA, voffA); PG8_STAGE(PG8_SA(0, 1), cA + hstep, voffA);
    if (wr == 1) PG8_BAR;
    PG8_WAIT_V(2); PG8_BAR;
    PG8_STAGE(PG8_SB(1, 0), cB + kstep, voffB); PG8_STAGE(PG8_SA(1, 0), cA + kstep, voffA); PG8_STAGE(PG8_SB(1, 1), cB + hstep + kstep, voffB);
    PG8_WAIT_V(6); PG8_BAR;
    for (;;) {
        nxt.keep = 0;
        const bool has_next = S.next(ui + 1, nxt);
        const char* nA = has_next ? nxt.a : cA; const char* nB = has_next ? nxt.b : cB;
        const int nt = cur.nt;
        for (int t = 0; t < nt; t += 2) {
            if constexpr (Epi::HAS_MID) { if (t == Epi::MID_T) E.mid(acc, cur, wr, wc, fr, fq); }
            const bool last = (t == nt - 2);
            const char* a1 = cA + (size_t)(t + 1) * kstep;
            const char* a2 = last ? nA : cA + (size_t)(t + 2) * kstep; const char* b2 = last ? nB : cB + (size_t)(t + 2) * kstep;
            const char* a3 = a2 + kstep; const char* b3 = b2 + kstep;
            PG8_LDB(B0, 0, 0); PG8_LDB(B1, 0, 1); PG8_SCHED; PG8_LDA(At, 0, 0); PG8_STAGE(PG8_SA(1, 1), a1 + hstep, voffA);
            PG8_WAIT_V(8); PG8_WAIT_L(0); PG8_BAR; PG8_MMA(0, 0, At, B0); PG8_MMA(0, 1, At, B1); PG8_BAR; PG8_SCHED;
            PG8_LDA(At, 0, 1); PG8_STAGE(PG8_SB(0, 0), b2, voffB); PG8_STAGE(PG8_SB(0, 1), b2 + hstep, voffB); PG8_STAGE(PG8_SA(0, 0), a2, voffA);
            PG8_WAIT_V(8); PG8_WAIT_L(0); PG8_BAR; PG8_MMA(1, 0, At, B0); PG8_MMA(1, 1, At, B1); PG8_BAR; PG8_SCHED;
            PG8_LDB(B0, 1, 0); PG8_LDB(B1, 1, 1); PG8_SCHED; PG8_LDA(At, 1, 0); PG8_STAGE(PG8_SA(0, 1), a2 + hstep, voffA);
            PG8_WAIT_V(8); PG8_WAIT_L(0); PG8_BAR; PG8_MMA(0, 0, At, B0); PG8_MMA(0, 1, At, B1); PG8_BAR; PG8_SCHED;
            PG8_LDA(At, 1, 1); PG8_STAGE(PG8_SB(1, 0), b3, voffB); PG8_STAGE(PG8_SB(1, 1), b3 + hstep, voffB); PG8_STAGE(PG8_SA(1, 0), a3, voffA);
            PG8_WAIT_V(8); PG8_WAIT_L(0); PG8_BAR; PG8_MMA(1, 0, At, B0); PG8_MMA(1, 1, At, B1); PG8_BAR; PG8_SCHED;
        }
        if (wr == 0) PG8_BAR;
        E(acc, cur, wr, wc, fr, fq);
        if (!has_next) break;
        if (!nxt.keep) {
#pragma unroll
        for (int a = 0; a < 2; ++a)
#pragma unroll
            for (int b = 0; b < 2; ++b)
#pragma unroll
                for (int m = 0; m < 4; ++m)
#pragma unroll
                    for (int n = 0; n < 2; ++n) acc[a][b][m][n] = (f32x4){0.f, 0.f, 0.f, 0.f};
        }
        cur = nxt; cA = nA; cB = nB; ++ui;
        if (wr == 1) PG8_BAR;
    }
    PG8_WAIT_V(0);
    PG8_BAR;
#undef PG8_SA
#undef PG8_SB
#undef PG8_STAGE
#undef PG8_LDA
#undef PG8_LDB
#undef PG8_MMA
#undef PG8_WAIT_V
#undef PG8_WAIT_L
#undef PG8_BAR
#undef PG8_SCHED
}

typedef const f32x4 (&AccRef)[2][2][4][2];

__device__ __forceinline__ void epi_act(AccRef acc, bf16_t* O, int ld, int act, int wr, int wc, int fr, int fq) {
#pragma unroll
    for (int ai = 0; ai < 2; ++ai)
#pragma unroll
        for (int m = 0; m < 4; ++m) { bf16_t* rowp = O + (size_t)(ai * HALF + wr * 64 + m * 16 + fr) * ld + wc * 32 + 8 * fq;
#pragma unroll
            for (int bj = 0; bj < 2; ++bj) { f32x4 v0 = acc[ai][bj][m][0], v1 = acc[ai][bj][m][1];
                if (act != 0) {
#pragma unroll
                    for (int e = 0; e < 4; ++e) { const float s0 = sigmoidf_(v0[e]), s1 = sigmoidf_(v1[e]); v0[e] = act == 1 ? v0[e] * s0 : s0; v1[e] = act == 1 ? v1[e] * s1 : s1; } }
                u32x4 w; w.x = cvt_pk_bf16(v0[0], v0[1]); w.y = cvt_pk_bf16(v0[2], v0[3]); w.z = cvt_pk_bf16(v1[0], v1[1]); w.w = cvt_pk_bf16(v1[2], v1[3]);
                *(u32x4*)(rowp + bj * HALF) = w; }
            if (m & 1) asm volatile("" ::: "memory"); }
}
__device__ __forceinline__ void epi_qk(AccRef acc, bf16_t* O, int ld, const float* g, const float* rope, int tok0, LAS float* X, int wr, int wc, int fr, int fq) {
#pragma unroll
    for (int ai = 0; ai < 2; ++ai)
#pragma unroll
        for (int m = 0; m < 4; ++m)
#pragma unroll
            for (int bj = 0; bj < 2; ++bj) { const f32x4 a = acc[ai][bj][m][0], b = acc[ai][bj][m][1];
                float s = (a[0] * a[0] + a[1] * a[1]) + (a[2] * a[2] + a[3] * a[3]) + (b[0] * b[0] + b[1] * b[1]) + (b[2] * b[2] + b[3] * b[3]);
                s += __shfl_xor(s, 16); s += __shfl_xor(s, 32);
                if (fq == 0) X[((ai * HALF + wr * 64 + m * 16 + fr) * 2 + bj) * 4 + wc] = s; }
    asm volatile("s_waitcnt lgkmcnt(0)" ::: "memory"); __builtin_amdgcn_s_barrier(); asm volatile("" ::: "memory");
    const int axis = wc >> 1, f0 = (wc & 1) * 16 + 4 * fq;
    const f32x4 g1 = *(const f32x4*)(g + axis * 64 + f0), g2 = *(const f32x4*)(g + axis * 64 + 32 + f0);
#pragma unroll
    for (int ai = 0; ai < 2; ++ai)
#pragma unroll
        for (int m = 0; m < 4; ++m) { const int rowl = ai * HALF + wr * 64 + m * 16 + fr;
            f32x4 cs0 = (f32x4){1.f, 0.f, 1.f, 0.f}, cs1 = cs0;
            if (rope) { const int n = tok0 + rowl, pos = axis ? (n & 63) : (n >> 6); const float* p = rope + (pos * 32 + f0) * 2; cs0 = *(const f32x4*)p; cs1 = *(const f32x4*)(p + 4); }
            const float co[4] = {cs0[0], cs0[2], cs1[0], cs1[2]}, si[4] = {cs0[1], cs0[3], cs1[1], cs1[3]};
#pragma unroll
            for (int bj = 0; bj < 2; ++bj) { const f32x4 part = *(const LAS f32x4*)(X + (rowl * 2 + bj) * 4);
                const float rstd = __builtin_amdgcn_rsqf(((part[0] + part[1]) + (part[2] + part[3])) * (1.f / 128.f) + EPS);
                const f32x4 x1 = acc[ai][bj][m][0] * rstd * g1, x2 = acc[ai][bj][m][1] * rstd * g2; float o1[4], o2[4];
#pragma unroll
                for (int e = 0; e < 4; ++e) { o1[e] = x1[e] * co[e] - x2[e] * si[e]; o2[e] = x2[e] * co[e] + x1[e] * si[e]; }
                u32x4 w; w.x = cvt_pk_bf16(o1[0], o1[1]); w.y = cvt_pk_bf16(o1[2], o1[3]); w.z = cvt_pk_bf16(o2[0], o2[1]); w.w = cvt_pk_bf16(o2[2], o2[3]);
                *(u32x4*)(O + (size_t)rowl * ld + bj * HALF + wc * 32 + 8 * fq) = w; }
            asm volatile("" ::: "memory"); }
}
__device__ __forceinline__ void epi_mul(AccRef acc, bf16_t* O, int ldo, const bf16_t* A1, int ld, int wr, int wc, int fr, int fq) {
#pragma unroll
    for (int ai = 0; ai < 2; ++ai)
#pragma unroll
        for (int m = 0; m < 4; ++m) { const int rl = ai * HALF + wr * 64 + m * 16 + fr, cl = wc * 32 + 8 * fq;
#pragma unroll
            for (int bj = 0; bj < 2; ++bj) { const u32x4 q1 = *(const u32x4*)(A1 + (size_t)rl * ld + cl + bj * HALF);
                f32x4 v0 = acc[ai][bj][m][0], v1 = acc[ai][bj][m][1];
                v0[0] *= bf_lo(q1.x); v0[1] *= bf_hi(q1.x); v0[2] *= bf_lo(q1.y); v0[3] *= bf_hi(q1.y); v1[0] *= bf_lo(q1.z); v1[1] *= bf_hi(q1.z); v1[2] *= bf_lo(q1.w); v1[3] *= bf_hi(q1.w);
                u32x4 w; w.x = cvt_pk_bf16(v0[0], v0[1]); w.y = cvt_pk_bf16(v0[2], v0[3]); w.z = cvt_pk_bf16(v1[0], v1[1]); w.w = cvt_pk_bf16(v1[2], v1[3]);
                *(u32x4*)(O + (size_t)rl * ldo + cl + bj * HALF) = w; }
            if (m == 3) asm volatile("" ::: "memory"); }
}
__device__ __forceinline__ void epi_ratio(f32x4 (&acc)[2][2][4][2], const bf16_t* GAo, const bf16_t* GBo, int wr, int wc, int fr, int fq) {
#pragma unroll
    for (int ai = 0; ai < 2; ++ai)
#pragma unroll
        for (int m = 0; m < 4; ++m) { const size_t ro = (size_t)(ai * HALF + wr * 64 + m * 16 + fr) * DM + wc * 32 + 8 * fq;
#pragma unroll
            for (int bj = 0; bj < 2; ++bj) { const u32x4 qa = *(const u32x4*)(GAo + ro + bj * HALF), qb = *(const u32x4*)(GBo + ro + bj * HALF);
                f32x4& v0 = acc[ai][bj][m][0]; f32x4& v1 = acc[ai][bj][m][1];
                v0[0] *= bf_lo(qb.x) * __builtin_amdgcn_rcpf(bf_lo(qa.x)); v0[1] *= bf_hi(qb.x) * __builtin_amdgcn_rcpf(bf_hi(qa.x));
                v0[2] *= bf_lo(qb.y) * __builtin_amdgcn_rcpf(bf_lo(qa.y)); v0[3] *= bf_hi(qb.y) * __builtin_amdgcn_rcpf(bf_hi(qa.y));
                v1[0] *= bf_lo(qb.z) * __builtin_amdgcn_rcpf(bf_lo(qa.z)); v1[1] *= bf_hi(qb.z) * __builtin_amdgcn_rcpf(bf_hi(qa.z));
                v1[2] *= bf_lo(qb.w) * __builtin_amdgcn_rcpf(bf_lo(qa.w)); v1[3] *= bf_hi(qb.w) * __builtin_amdgcn_rcpf(bf_hi(qa.w)); }
            if (m == 3) asm volatile("" ::: "memory"); }
}
__device__ __forceinline__ void epi_m1(f32x4 (&acc)[2][2][4][2], bf16_t* O, const bf16_t* NUM, const bf16_t* DEN, bool store, int wr, int wc, int fr, int fq) {
#pragma unroll
    for (int ai = 0; ai < 2; ++ai)
#pragma unroll
        for (int m = 0; m < 4; ++m) { const size_t ro = (size_t)(ai * HALF + wr * 64 + m * 16 + fr) * DM + wc * 32 + 8 * fq;
#pragma unroll
            for (int bj = 0; bj < 2; ++bj) { const u32x4 qn = *(const u32x4*)(NUM + ro + bj * HALF);
                float f[8] = {bf_lo(qn.x), bf_hi(qn.x), bf_lo(qn.y), bf_hi(qn.y), bf_lo(qn.z), bf_hi(qn.z), bf_lo(qn.w), bf_hi(qn.w)};
                if (DEN) { const u32x4 qd = *(const u32x4*)(DEN + ro + bj * HALF);
                    const float d[8] = {bf_lo(qd.x), bf_hi(qd.x), bf_lo(qd.y), bf_hi(qd.y), bf_lo(qd.z), bf_hi(qd.z), bf_lo(qd.w), bf_hi(qd.w)};
#pragma unroll
                    for (int e = 0; e < 8; ++e) f[e] *= __builtin_amdgcn_rcpf(d[e]); }
                f32x4& v0 = acc[ai][bj][m][0]; f32x4& v1 = acc[ai][bj][m][1];
                v0[0] *= f[0]; v0[1] *= f[1]; v0[2] *= f[2]; v0[3] *= f[3]; v1[0] *= f[4]; v1[1] *= f[5]; v1[2] *= f[6]; v1[3] *= f[7];
                if (store) { u32x4 w; w.x = cvt_pk_bf16(v0[0], v0[1]); w.y = cvt_pk_bf16(v0[2], v0[3]); w.z = cvt_pk_bf16(v1[0], v1[1]); w.w = cvt_pk_bf16(v1[2], v1[3]);
                    *(u32x4*)(O + ro + bj * HALF) = w; } }
            if (m == 3) asm volatile("" ::: "memory"); }
}
template <bool IN_BF>
__device__ __forceinline__ void epi_res(AccRef acc, bf16_t* O, const void* Xin, const float* gate, int wr, int wc, int fr, int fq) {
    f32x4 gv[2][2];
#pragma unroll
    for (int bj = 0; bj < 2; ++bj)
#pragma unroll
        for (int n = 0; n < 2; ++n) gv[bj][n] = *(const f32x4*)(gate + bj * HALF + wc * 32 + 8 * fq + 4 * n);
#pragma unroll
    for (int ai = 0; ai < 2; ++ai)
#pragma unroll
        for (int m = 0; m < 4; ++m) { const size_t ro = (size_t)(ai * HALF + wr * 64 + m * 16 + fr) * DM + wc * 32 + 8 * fq;
#pragma unroll
            for (int bj = 0; bj < 2; ++bj) { const size_t off = ro + bj * HALF; f32x4 x0, x1;
                if (IN_BF) { const u32x4 q = *(const u32x4*)((const bf16_t*)Xin + off); x0 = (f32x4){bf_lo(q.x), bf_hi(q.x), bf_lo(q.y), bf_hi(q.y)}; x1 = (f32x4){bf_lo(q.z), bf_hi(q.z), bf_lo(q.w), bf_hi(q.w)}; }
                else { x0 = *(const f32x4*)((const float*)Xin + off); x1 = *(const f32x4*)((const float*)Xin + off + 4); }
                const f32x4 o0 = x0 + gv[bj][0] * acc[ai][bj][m][0], o1 = x1 + gv[bj][1] * acc[ai][bj][m][1];
                u32x4 w; w.x = cvt_pk_bf16(o0[0], o0[1]); w.y = cvt_pk_bf16(o0[2], o0[3]); w.z = cvt_pk_bf16(o1[0], o1[1]); w.w = cvt_pk_bf16(o1[2], o1[3]);
                *(u32x4*)(O + off) = w; }
            if (m == 3) asm volatile("" ::: "memory"); }
}
__device__ __forceinline__ void epi_res_final(f32x4 (&acc)[2][2][4][2], const bf16_t* Xin, const float* gate, float* Fo, const float* fg, float* slots, unsigned* cnt, int pn, LAS float* PL, int wr, int wc, int fr, int fq) {
    int tid = threadIdx.x; asm volatile("" : "+v"(tid));
    const int wid = __builtin_amdgcn_readfirstlane(tid >> 6), lane = tid & 63;
    {   f32x4 gv[2][2];
#pragma unroll
        for (int bj = 0; bj < 2; ++bj)
#pragma unroll
            for (int n = 0; n < 2; ++n) gv[bj][n] = *(const f32x4*)(gate + bj * HALF + wc * 32 + 8 * fq + 4 * n);
#pragma unroll
        for (int ai = 0; ai < 2; ++ai)
#pragma unroll
            for (int m = 0; m < 4; ++m) { const size_t ro = (size_t)(ai * HALF + wr * 64 + m * 16 + fr) * DM + wc * 32 + 8 * fq; float s = 0.f;
#pragma unroll
                for (int bj = 0; bj < 2; ++bj) { const u32x4 q = *(const u32x4*)(Xin + ro + bj * HALF);
                    const f32x4 x0 = (f32x4){bf_lo(q.x), bf_hi(q.x), bf_lo(q.y), bf_hi(q.y)}, x1 = (f32x4){bf_lo(q.z), bf_hi(q.z), bf_lo(q.w), bf_hi(q.w)};
                    const f32x4 o0 = x0 + gv[bj][0] * acc[ai][bj][m][0], o1 = x1 + gv[bj][1] * acc[ai][bj][m][1];
                    acc[ai][bj][m][0] = o0; acc[ai][bj][m][1] = o1;
                    s += (o0[0] * o0[0] + o0[1] * o0[1]) + (o0[2] * o0[2] + o0[3] * o0[3]) + (o1[0] * o1[0] + o1[1] * o1[1]) + (o1[2] * o1[2] + o1[3] * o1[3]); }
                s += __shfl_xor(s, 16); s += __shfl_xor(s, 32);
                if (fq == 0) PL[(ai * HALF + wr * 64 + m * 16 + fr) * 4 + wc] = s;
                if (m == 3) asm volatile("" ::: "memory"); }
    }
    asm volatile("s_waitcnt lgkmcnt(0)" ::: "memory"); __builtin_amdgcn_s_barrier(); asm volatile("" ::: "memory");
    const int row = wid * 32 + (lane & 31);
    if (lane < 32) { const f32x4 p = *(const LAS f32x4*)(PL + row * 4); __hip_atomic_store(slots + row * 8 + pn, (p[0] + p[1]) + (p[2] + p[3]), __ATOMIC_RELAXED, __HIP_MEMORY_SCOPE_AGENT); }
    asm volatile("s_waitcnt vmcnt(0)" ::: "memory");
    if (lane == 0) (void)__hip_atomic_fetch_add(cnt, 1u, __ATOMIC_RELAXED, __HIP_MEMORY_SCOPE_AGENT);
    if (wid == 0) { unsigned sp = 0;
        while ((unsigned)__builtin_amdgcn_readfirstlane(__hip_atomic_load(cnt, __ATOMIC_RELAXED, __HIP_MEMORY_SCOPE_AGENT)) < 64u) { __builtin_amdgcn_s_sleep(2); if (++sp > (1u << 21)) break; }
        __builtin_amdgcn_fence(__ATOMIC_ACQUIRE, "agent"); }
    asm volatile("s_waitcnt vmcnt(0) lgkmcnt(0)" ::: "memory"); __builtin_amdgcn_s_barrier(); asm volatile("" ::: "memory");
    if (lane < 32) { float t = 0.f;
#pragma unroll
        for (int k = 0; k < 8; ++k) t += __hip_atomic_load(slots + row * 8 + k, __ATOMIC_RELAXED, __HIP_MEMORY_SCOPE_AGENT);
        PL[1024 + row] = __builtin_amdgcn_rsqf(t * (1.f / DM) + EPS); }
    asm volatile("s_waitcnt vmcnt(0) lgkmcnt(0)" ::: "memory"); __builtin_amdgcn_s_barrier(); asm volatile("" ::: "memory");
    {   f32x4 gf[2][2];
#pragma unroll
        for (int bj = 0; bj < 2; ++bj)
#pragma unroll
            for (int n = 0; n < 2; ++n) gf[bj][n] = *(const f32x4*)(fg + bj * HALF + wc * 32 + 8 * fq + 4 * n);
#pragma unroll
        for (int ai = 0; ai < 2; ++ai)
#pragma unroll
            for (int m = 0; m < 4; ++m) { const int rl = ai * HALF + wr * 64 + m * 16 + fr; const float rstd = PL[1024 + rl]; float* op = Fo + (size_t)rl * DM + wc * 32 + 8 * fq;
#pragma unroll
                for (int bj = 0; bj < 2; ++bj)
#pragma unroll
                    for (int n = 0; n < 2; ++n) *(f32x4*)(op + bj * HALF + 4 * n) = acc[ai][bj][m][n] * rstd * gf[bj][n]; }
    }
}
}

enum { KQ = 0, KK = 1, KACT = 2, KUB = 3 };
struct G1Sched {
    int Gq, cq, nM, nA, n1, n2, Lbase, Lend, split; const char* H; const char* W;
    __device__ __forceinline__ bool next(int i, pg8::Unit& u) const {
        if (cq < 0 || cq >= Gq) return false;
        int L = Lbase + i * Gq + cq; if (L >= Lend) return false;
        u.nt = DM / 64;
        if (L < nA) { int pm, j; pg8::tile_decode(L, nM, 18, pm, j); const int pn = ufl(j < 16 ? j : j + 4); pm = ufl(pm);
            u.kind = pn < 6 ? KQ : (pn < 8 ? KK : KACT); u.pm = pm; u.pn = pn; u.a = H + (size_t)pm * MiB; u.b = W + (size_t)pn * MiB; return true; }
        L -= nA;
        if (L < n1) { int pc, tt; pg8::tile_decode(L, 4, nM, pc, tt); pc = ufl(pc); tt = ufl(tt); u.kind = KUB; u.pm = pc; u.pn = tt; u.a = W + (size_t)(16 + pc) * MiB; u.b = H + (size_t)tt * MiB; return true; }
        L -= n1;
        if (L < n2) { const int pm = 32 + (L & 3), pn = 6 + (L >> 2); u.kind = pn < 8 ? KK : KACT; u.pm = pm; u.pn = pn; u.a = H + (size_t)pm * MiB; u.b = W + (size_t)pn * MiB; return true; }
        L -= n2;
        int pm, j, pn;
        if (!split) { pg8::tile_decode(L, nM, 16, pm, j); pn = 22 + j; }
        else if (L < (nM - 6) * 16) { pg8::tile_decode(L, nM - 6, 16, pm, j); pm += 6; pn = 22 + j; }
        else if (L < (nM - 6) * 16 + 8) { pm = 5; pn = 22 + (L - (nM - 6) * 16); }
        else if (L < (nM - 6) * 16 + 8 + 80) { pg8::tile_decode(L - (nM - 6) * 16 - 8, 5, 16, pm, j); pn = 22 + j; }
        else { pm = 5; pn = 30 + (L - (nM - 6) * 16 - 88); }
        pm = ufl(pm); pn = ufl(pn); u.kind = KACT; u.pm = pm; u.pn = pn; u.a = H + (size_t)pm * MiB; u.b = W + (size_t)pn * MiB; return true;
    }
};
struct G1Epi {
    static constexpr bool HAS_MID = false; static constexpr int MID_T = 0;
    unsigned char* ws; const float *qg, *kg; LAS float* X;
    __device__ __forceinline__ void operator()(pg8::AccRef acc, const pg8::Unit& u, int wr, int wc, int fr, int fq) const {
        asm volatile("" : "+v"(fr), "+v"(fq));
        const int pm = u.pm, pn = u.pn; const float* rope = (const float*)(ws + WS_TAB);
        if (u.kind == KQ) {
            pg8::epi_qk(acc, (bf16_t*)(ws + WS_Q) + (size_t)pm * 256 * 1536 + pn * 256, 1536, qg, pm < 32 ? rope : nullptr, (pm & 7) * 256, X, wr, wc, fr, fq);
        } else if (u.kind == KK) {
            const int kvrow0 = pm < 32 ? pm * 256 + (pm >> 3) * 256 : (pm - 32) * KEYS + SEQ;
            pg8::epi_qk(acc, (bf16_t*)(ws + WS_K) + (size_t)kvrow0 * 512 + (pn - 6) * 256, 512, kg, pm < 32 ? rope : nullptr, (pm & 7) * 256, X, wr, wc, fr, fq);
        } else {
            bf16_t* O; int ld, act = 0;
            if (u.kind == KUB) { const int cs = pm >> 1, chb = (pm & 1) * 256;
                if (pn < 32) { O = (bf16_t*)(ws + WS_UT) + ((size_t)((pn >> 3) * 512 + chb)) * 4096 + cs * 2048 + (pn & 7) * 256; ld = 4096; }
                else { O = (bf16_t*)(ws + WS_UTC) + ((size_t)((pn - 32) * 512 + chb)) * 512 + cs * 256; ld = 512; } }
            else if (pn < 10) { const int kvrow0 = pm < 32 ? pm * 256 + (pm >> 3) * 256 : (pm - 32) * KEYS + SEQ; O = (bf16_t*)(ws + WS_V) + (size_t)kvrow0 * 512 + (pn - 8) * 256; ld = 512; }
            else if (pn < 16) { O = (bf16_t*)(ws + WS_ZA) + (size_t)pm * 256 * 1536 + (pn - 10) * 256; ld = 1536; act = 1; }
            else if (pn < 22) { O = (bf16_t*)(ws + WS_ZB) + (size_t)pm * 256 * 512 + (pn - 20) * 256; ld = 512; act = 1; }
            else if (pn < 30) { O = (bf16_t*)(ws + WS_GA) + (size_t)pm * 256 * 2048 + (pn - 22) * 256; ld = 2048; act = 2; }
            else { O = (bf16_t*)(ws + WS_GB) + (size_t)pm * 256 * 2048 + (pn - 30) * 256; ld = 2048; act = 2; }
            pg8::epi_act(acc, O, ld, act, wr, wc, fr, fq);
        }
    }
};
struct GridSched {
    int G, c, nM, nN, nt; const char* A; const char* B; size_t astep, bstep;
    __device__ __forceinline__ bool next(int i, pg8::Unit& u) const {
        const int L = i * G + c; if (L >= nM * nN) return false;
        int pm, pn; pg8::tile_decode(L, nM, nN, pm, pn); pm = ufl(pm); pn = ufl(pn); u.kind = 0; u.nt = nt; u.pm = pm; u.pn = pn; u.a = A + (size_t)pm * astep; u.b = B + (size_t)pn * bstep; return true;
    }
};
struct FnSched {
    int G, c, cu0, nunits, ntn, nt; const char* A; const char* B; size_t astep, bstep, bbatch; int row_base, rows_per_b;
    __device__ __forceinline__ bool next(int i, pg8::Unit& u) const {
        const int L = ufl(i * G + ((c - cu0 + 4 * G) % G)); if (L >= nunits) return false;
        const int pn = L & 1, pmn = ufl((L >> 1) % ntn), b = ufl((L >> 1) / ntn);
        u.kind = 0; u.nt = nt; u.pm = row_base + b * rows_per_b + pmn * 256;   u.pn = pn; u.a = A + (size_t)pmn * astep; u.b = B + (size_t)b * bbatch + (size_t)pn * bstep; return true;
    }
};
struct FnEpi {
    static constexpr bool HAS_MID = false; static constexpr int MID_T = 0;
    bf16_t* ACAT; const bf16_t* ZB;
    __device__ __forceinline__ void operator()(pg8::AccRef acc, const pg8::Unit& u, int wr, int wc, int fr, int fq) const {
        asm volatile("" : "+v"(fr), "+v"(fq));
        pg8::epi_mul(acc, ACAT + (size_t)u.pm * DM + u.pn * 256, DM, ZB + (size_t)u.pm * 512 + u.pn * 256, 512, wr, wc, fr, fq);
    }
};
__device__ __forceinline__ void m1_sub(pg8::Unit& u, int pm, int pn, int sub, int odd, const char* A, const char* B) {
    const bool ybpart = (sub == 0) != (odd != 0);
    u.pm = pm; u.pn = pn; u.nt = ybpart ? 8 : 24; const size_t ko = ybpart ? 0 : 1024;
    u.a = A + (size_t)pm * MiB + ko; u.b = B + (size_t)pn * MiB + ko; u.keep = sub; u.kind = sub * 2 + odd;
}
struct M1Sched {
    int G, c, nM; const char* A; const char* B;
    __device__ __forceinline__ bool next(int i, pg8::Unit& u) const {
        const int L = (i >> 1) * G + c; if (L >= nM * 8) return false;
        int pm, pn; pg8::tile_decode(L, nM, 8, pm, pn); m1_sub(u, ufl(pm), ufl(pn), i & 1, c & 1, A, B); return true;
    }
};
struct M1Epi {
    static constexpr bool HAS_MID = false; static constexpr int MID_T = 0;
    bf16_t* MMo; const bf16_t* GA; const bf16_t* GB;
    __device__ __forceinline__ void operator()(f32x4 (&acc)[2][2][4][2], const pg8::Unit& u, int wr, int wc, int fr, int fq) const {
        asm volatile("" : "+v"(fr), "+v"(fq));
        const size_t o = (size_t)u.pm * 256 * DM + u.pn * 256;
        const bool odd = u.kind & 1, fin = u.kind >= 2;
        const bf16_t* num = (fin ? (odd ? GB : GA) : (odd ? GA : GB)) + o; const bf16_t* den = fin ? nullptr : (odd ? GB : GA) + o;
        pg8::epi_m1(acc, MMo + o, num, den, fin, wr, wc, fr, fq);
    }
};
struct CtxM1Sched {
    int cq; const char* A; const char* B;
    __device__ __forceinline__ bool next(int i, pg8::Unit& u) const {
        if (i > 1 || cq < 0 || cq >= 32) return false;
        m1_sub(u, 32 + (cq >> 3), cq & 7, i, cq & 1, A, B); return true;
    }
};
struct FoldSched {
    int G, c; const char* Tt; const char* Wub;
    __device__ __forceinline__ bool next(int i, pg8::Unit& u) const {
        const int L = i * G + c; if (L >= 64) return false;
        int two = 2; asm volatile("" : "+s"(two));
        u.kind = 0; u.nt = two; u.pm = L >> 3; u.pn = L & 7; u.a = Tt; u.b = Wub + (size_t)(L >> 3) * (512 * 1024) + (size_t)(L & 7) * 65536; return true;
    }
};
struct FoldEpi {
    static constexpr bool HAS_MID = false; static constexpr int MID_T = 0;
    unsigned char* ws;
    __device__ __forceinline__ void operator()(pg8::AccRef acc, const pg8::Unit& u, int wr, int wc, int fr, int fq) const {
        asm volatile("" : "+v"(fr), "+v"(fq));
        const int l2 = u.pm >> 2, g = u.pm & 3; bf16_t* WT = (bf16_t*)(ws + WS_WIN + (size_t)l2 * 38 * MiB) + (size_t)(4096 + g * 128) * DM + u.pn * 256;
#pragma unroll
        for (int ai = 0; ai < 2; ++ai)
#pragma unroll
            for (int m = 0; m < 4; ++m) { bf16_t* rowp = WT + (size_t)(ai * 512 + wr * 64 + m * 16 + fr) * DM + wc * 32 + 8 * fq;
#pragma unroll
                for (int bj = 0; bj < 2; ++bj) { const f32x4 v0 = acc[ai][bj][m][0], v1 = acc[ai][bj][m][1];
                    u32x4 w; w.x = cvt_pk_bf16(v0[0], v0[1]); w.y = cvt_pk_bf16(v0[2], v0[3]); w.z = cvt_pk_bf16(v1[0], v1[1]); w.w = cvt_pk_bf16(v1[2], v1[3]);
                    *(u32x4*)(rowp + bj * 128) = w; } }
    }
};
struct OSched {
    int G, c, nctx; const char* A; const char* B;
    __device__ __forceinline__ bool next(int i, pg8::Unit& u) const {
        int L = i * G + c;
        if (G == 256 && c < nctx && i < 2) L = (i == 0) ? 256 + c : c;
        if (L < 256) { int pm, pn; pg8::tile_decode(L, 32, 8, pm, pn); pm = ufl(pm); pn = ufl(pn); u.kind = 0; u.nt = 32; u.pm = pm; u.pn = pn; u.a = A + (size_t)pm * MiB; u.b = B + (size_t)pn * MiB; return true; }
        const int s = L - 256; if (s >= nctx) return false;
        const int ch = s & 3, pn = (s >> 2) & 7, pm = 32 + (s >> 5);
        u.kind = 1 + ch; u.nt = 8; u.pm = pm; u.pn = pn; u.a = A + (size_t)pm * MiB + ch * 1024; u.b = B + (size_t)pn * MiB + ch * 1024; return true;
    }
};
struct ResEpi {
    static constexpr bool HAS_MID = false; static constexpr int MID_T = 0;
    bf16_t* out; const void* xin; int in_bf; float* cs_out; const float* gate; int fuse; float* fout; const float* fg; unsigned char* ctl; LAS float* PL;
    __device__ __forceinline__ void operator()(f32x4 (&acc)[2][2][4][2], const pg8::Unit& u, int wr, int wc, int fr, int fq) const {
        if (fuse && u.kind == 0) { asm volatile("" : "+v"(fr), "+v"(fq)); const int pm = u.pm, pn = u.pn; const size_t o = (size_t)pm * 256 * DM + pn * 256;
            pg8::epi_res_final(acc, (const bf16_t*)xin + o, gate + (size_t)(pm >> 3) * 6144 + pn * 256, fout + o, fg + pn * 256, (float*)(ctl + 65536) + (size_t)pm * 256 * 8, (unsigned*)ctl + 4096 + 64 * pm, pn, PL, wr, wc, fr, fq); }
        else (*this)((pg8::AccRef)acc, u, wr, wc, fr, fq);
    }
    bf16_t* out_;
    __device__ __forceinline__ void operator()(pg8::AccRef acc, const pg8::Unit& u, int wr, int wc, int fr, int fq) const {
        asm volatile("" : "+v"(fr), "+v"(fq));
        const int pm = u.pm, pn = u.pn;
        if (u.kind == 0) { const size_t o = (size_t)pm * 256 * DM + pn * 256; const float* gt = gate + (size_t)(pm >> 3) * 6144 + pn * 256;
            if (in_bf) pg8::epi_res<true>(acc, out + o, (const bf16_t*)xin + o, gt, wr, wc, fr, fq); else pg8::epi_res<false>(acc, out + o, (const float*)xin + o, gt, wr, wc, fr, fq); }
        else { float* O = cs_out + (size_t)(u.kind - 1) * MC * DM + (size_t)(pm - 32) * 256 * DM + pn * 256; const float* gt = gate + (size_t)4 * 6144 + pn * 256;
#pragma unroll
            for (int bj = 0; bj < 2; ++bj)
#pragma unroll
                for (int n = 0; n < 2; ++n) { const f32x4 gv = *(const f32x4*)(gt + bj * 128 + wc * 32 + 8 * fq + 4 * n);
#pragma unroll
                    for (int ai = 0; ai < 2; ++ai)
#pragma unroll
                        for (int m = 0; m < 4; ++m) *(f32x4*)(O + (size_t)(ai * 128 + wr * 64 + m * 16 + fr) * DM + bj * 128 + wc * 32 + 8 * fq + 4 * n) = gv * acc[ai][bj][m][n]; }
        }
    }
};

namespace att {
constexpr int D = 128, NW = 8, QBLK = 32, KVBLK = 64;
constexpr float SCALE = 0.088388347648318440f;
constexpr float THR = 8.f;
constexpr int LDQ = 1536, LDK = 512, LDZ = 1536, LDO = 2048;
constexpr size_t SHM_V = KVBLK * D * 2, SHM_K = KVBLK * D * 2, SHM_ATTN = 2 * SHM_V + 2 * SHM_K + NW * 64 * 4;
#define KSWZ(row, colB) ((row) * 256 + ((colB) ^ (((row) & 7) << 4)))
#define SBAR() __builtin_amdgcn_sched_barrier(0)
__device__ __forceinline__ int crow(int r, int hi) { return (r & 3) + 8 * (r >> 2) + 4 * hi; }
__device__ __forceinline__ unsigned cvtpk(float lo, float hi) { unsigned r; asm volatile("v_cvt_pk_bf16_f32 %0, %1, %2" : "=v"(r) : "v"(lo), "v"(hi)); return r; }
__device__ __forceinline__ void partialSM(f32x16& p0, f32x16& p1, float& m_reg, float& mn, float& alpha) {
  constexpr float C = SCALE * 1.4426950408889634f;
  float pmax = p0[0]; for (int r = 1; r < 16; ++r) pmax = fmaxf(pmax, p0[r]); for (int r = 0; r < 16; ++r) pmax = fmaxf(pmax, p1[r]);
  { auto rr = __builtin_amdgcn_permlane32_swap(__float_as_uint(pmax), __float_as_uint(pmax), false, false);
    pmax = fmaxf(__uint_as_float(rr[0]), __uint_as_float(rr[1])); }
  if (__builtin_expect(__all(pmax - m_reg <= THR / SCALE), 1)) { mn = m_reg; alpha = 1.f; }
  else { mn = fmaxf(m_reg, pmax); alpha = __builtin_amdgcn_exp2f((m_reg - mn) * C); m_reg = mn; }
  float mnC = -mn * C;
  for (int r = 0; r < 16; ++r) p0[r] = fmaf(p0[r], C, mnC); for (int r = 0; r < 16; ++r) p1[r] = fmaf(p1[r], C, mnC);
  for (int r = 0; r < 16; ++r) p0[r] = __builtin_amdgcn_exp2f(p0[r]);
}
__device__ __forceinline__ void finishSM(f32x16& p0, f32x16& p1, float alpha, float& l_reg, bf16x8& pa0, bf16x8& pa1, bf16x8& pa2, bf16x8& pa3) {
  for (int r = 0; r < 16; ++r) p1[r] = __builtin_amdgcn_exp2f(p1[r]);
  float ps = 0; for (int r = 0; r < 16; ++r) ps += p0[r]; for (int r = 0; r < 16; ++r) ps += p1[r];
  { auto rr = __builtin_amdgcn_permlane32_swap(__float_as_uint(ps), __float_as_uint(ps), false, false);
    ps = __uint_as_float(rr[0]) + __uint_as_float(rr[1]); }
  l_reg = l_reg * alpha + ps;
#define PK4(P, BASE, OUT) do { unsigned a0 = cvtpk(P[BASE + 0], P[BASE + 1]), a1 = cvtpk(P[BASE + 2], P[BASE + 3]);   \
    unsigned b0 = cvtpk(P[BASE + 4], P[BASE + 5]), b1 = cvtpk(P[BASE + 6], P[BASE + 7]);                              \
    auto r0 = __builtin_amdgcn_permlane32_swap(a0, b0, false, false); auto r1 = __builtin_amdgcn_permlane32_swap(a1, b1, false, false); \
    u32x4 w = {r0[0], r1[0], r0[1], r1[1]}; OUT = *reinterpret_cast<bf16x8*>(&w); } while (0)
  PK4(p0, 0, pa0); PK4(p0, 8, pa1); PK4(p1, 0, pa2); PK4(p1, 8, pa3);
#undef PK4
}
__device__ __forceinline__ void qkt(f32x16& p0, f32x16& p1, const bf16_t* Ks, const bf16x8* qr, int r32, int hi) {
  p0 = f32x16{}; p1 = f32x16{};
  for (int d0 = 0; d0 < 8; ++d0) { int cb = (d0 * 16 + hi * 8) * 2;
    bf16x8 b0 = *reinterpret_cast<const bf16x8*>((const char*)Ks + KSWZ(r32, cb));
    bf16x8 b1 = *reinterpret_cast<const bf16x8*>((const char*)Ks + KSWZ(32 + r32, cb));
    p0 = __builtin_amdgcn_mfma_f32_32x32x16_bf16(b0, qr[d0], p0, 0, 0, 0);
    p1 = __builtin_amdgcn_mfma_f32_32x32x16_bf16(b1, qr[d0], p1, 0, 0, 0); }
}
__device__ __forceinline__ int v_st(int k, int c) { const int kk = (k & ~0xC) | ((k & 4) << 1) | ((k & 8) >> 1); return ((kk >> 3) * 4 + (c >> 5)) * 512 + ((kk & 7) * 32 + (c & 31)) * 2; }
__device__ __forceinline__ int v_rd_base(int lane) { return ((lane & 3) << 3) | (((lane >> 2) & 3) << 6) | (((lane >> 4) & 1) << 5) | (((lane >> 5) & 1) << 8); }
constexpr int v_rd_off(int d0, int ks, int half) { return d0 * 512 + ks * 4096 + half * 2048; }
template <int OFF> __device__ __forceinline__ s16x4 tr_read(int vb) {
  s16x4 r; asm volatile("ds_read_b64_tr_b16 %0, %1 offset:%2" : "=&v"(r) : "v"(vb), "i"(OFF) : "memory"); return r;
}
template <int D0> __device__ __forceinline__ void pv_one(f32x16& od, int vb, bf16x8 pa0, bf16x8 pa1, bf16x8 pa2, bf16x8 pa3) {
  const s16x4 l0 = tr_read<v_rd_off(D0, 0, 0)>(vb), h0 = tr_read<v_rd_off(D0, 0, 1)>(vb), l1 = tr_read<v_rd_off(D0, 1, 0)>(vb), h1 = tr_read<v_rd_off(D0, 1, 1)>(vb);
  const s16x4 l2 = tr_read<v_rd_off(D0, 2, 0)>(vb), h2 = tr_read<v_rd_off(D0, 2, 1)>(vb), l3 = tr_read<v_rd_off(D0, 3, 0)>(vb), h3 = tr_read<v_rd_off(D0, 3, 1)>(vb);
  asm volatile("s_waitcnt lgkmcnt(0)" ::: "memory"); SBAR();
#define PK(L, H) (bf16x8){L[0], L[1], L[2], L[3], H[0], H[1], H[2], H[3]}
  od = __builtin_amdgcn_mfma_f32_32x32x16_bf16(pa0, PK(l0, h0), od, 0, 0, 0);
  od = __builtin_amdgcn_mfma_f32_32x32x16_bf16(pa1, PK(l1, h1), od, 0, 0, 0);
  od = __builtin_amdgcn_mfma_f32_32x32x16_bf16(pa2, PK(l2, h2), od, 0, 0, 0);
  od = __builtin_amdgcn_mfma_f32_32x32x16_bf16(pa3, PK(l3, h3), od, 0, 0, 0);
#undef PK
}
__device__ __forceinline__ void pv_d0(f32x16* o, int vb, bf16x8 pa0, bf16x8 pa1, bf16x8 pa2, bf16x8 pa3) {
  pv_one<0>(o[0], vb, pa0, pa1, pa2, pa3); pv_one<1>(o[1], vb, pa0, pa1, pa2, pa3); pv_one<2>(o[2], vb, pa0, pa1, pa2, pa3); pv_one<3>(o[3], vb, pa0, pa1, pa2, pa3);
}
__device__ __forceinline__ void attn_dense_body(const bf16_t* __restrict__ Qb, const bf16_t* __restrict__ Kh, const bf16_t* __restrict__ Vh,
                                                const bf16_t* __restrict__ ZAb, bf16_t* __restrict__ AAb, int seq, char* lds) {
  int tid = threadIdx.x; asm volatile("" : "+v"(tid));
  const int wid = tid >> 6, lane = tid & 63, r32 = lane & 31, hi = lane >> 5;
  bf16_t* V_lds = (bf16_t*)lds; bf16_t* K_lds = (bf16_t*)(lds + 2 * SHM_V);
  float* ws = (float*)(lds + 2 * SHM_V + 2 * SHM_K) + wid * 64; float* li_l = ws; float* al_l = ws + 32;
  float m_reg = -1e30f, l_reg = 0; f32x16 o[4] = {}; bf16x8 qr[8];
  const bf16_t* Qw = Qb + (long)(wid * QBLK + r32) * LDQ + hi * 8;
#pragma unroll
  for (int d0 = 0; d0 < 8; ++d0) qr[d0] = *reinterpret_cast<const bf16x8*>(Qw + d0 * 16);
  const int sr = tid >> 4, sc = (tid & 15) * 8, vst0 = v_st(sr, sc), vst1 = v_st(32 + sr, sc);
  const int vb0 = (int)(uintptr_t)V_lds + v_rd_base(lane);
  struct { bf16x8 vs0, vs1, ks0, ks1; } sr_[2];
#define SLOAD(i, k0) do { sr_[i].vs0 = *reinterpret_cast<const bf16x8*>(&Vh[(long)((k0) + sr) * LDK + sc]); sr_[i].vs1 = *reinterpret_cast<const bf16x8*>(&Vh[(long)((k0) + 32 + sr) * LDK + sc]); \
    sr_[i].ks0 = *reinterpret_cast<const bf16x8*>(&Kh[(long)((k0) + sr) * LDK + sc]); sr_[i].ks1 = *reinterpret_cast<const bf16x8*>(&Kh[(long)((k0) + 32 + sr) * LDK + sc]); } while (0)
#define SWRITE(b, i) do { *(bf16x8*)((char*)V_lds + (b) * SHM_V + vst0) = sr_[i].vs0;          \
    *(bf16x8*)((char*)V_lds + (b) * SHM_V + vst1) = sr_[i].vs1; int kc = sc * 2;               \
    *(bf16x8*)((char*)K_lds + (b) * SHM_K + KSWZ(sr, kc)) = sr_[i].ks0;                       \
    *(bf16x8*)((char*)K_lds + (b) * SHM_K + KSWZ(32 + sr, kc)) = sr_[i].ks1; } while (0)
#define SWAIT() asm volatile("s_waitcnt vmcnt(4)" ::: "memory")
#define RESC(a) do { if (__any((a) < 1.f)) { if (hi == 0) al_l[r32] = (a); asm volatile("s_waitcnt lgkmcnt(0)" ::: "memory"); \
    for (int d = 0; d < 4; ++d) for (int r = 0; r < 16; ++r) o[d][r] *= al_l[crow(r, hi)]; } } while (0)
  f32x16 pA0, pA1, pB0, pB1; float mnA, mnB, alA, alB; bf16x8 pa0, pa1, pa2, pa3; const int NT = seq / KVBLK;
  constexpr int SE = 0, SO = 1;
  SLOAD(SE, 0); asm volatile("s_waitcnt vmcnt(0)" ::: "memory"); SWRITE(0, SE); __syncthreads();
  qkt(pA0, pA1, K_lds, qr, r32, hi); partialSM(pA0, pA1, m_reg, mnA, alA);
  SLOAD(SO, KVBLK); if (2 < NT) SLOAD(SE, 2 * KVBLK);
  SWAIT(); SWRITE(1, SO); __syncthreads();
  for (int j = 1; j + 1 < NT; j += 2) {
    SBAR(); qkt(pB0, pB1, (bf16_t*)((char*)K_lds + SHM_K), qr, r32, hi);
    finishSM(pA0, pA1, alA, l_reg, pa0, pa1, pa2, pa3); SBAR();
    SLOAD(SO, (j + 2) * KVBLK); SBAR();
    pv_d0(o, vb0, pa0, pa1, pa2, pa3); partialSM(pB0, pB1, m_reg, mnB, alB);
    __syncthreads(); SWAIT(); SWRITE(0, SE);
    RESC(alB); __syncthreads();
    SBAR(); qkt(pA0, pA1, K_lds, qr, r32, hi);
    finishSM(pB0, pB1, alB, l_reg, pa0, pa1, pa2, pa3); SBAR();
    if (j + 3 < NT) SLOAD(SE, (j + 3) * KVBLK); SBAR();
    pv_d0(o, vb0 + (int)SHM_V, pa0, pa1, pa2, pa3); partialSM(pA0, pA1, m_reg, mnA, alA);
    __syncthreads(); SWAIT(); SWRITE(1, SO);
    RESC(alA); __syncthreads();
  }
  SBAR(); qkt(pB0, pB1, (bf16_t*)((char*)K_lds + SHM_K), qr, r32, hi);
  finishSM(pA0, pA1, alA, l_reg, pa0, pa1, pa2, pa3); SBAR();
  pv_d0(o, vb0, pa0, pa1, pa2, pa3); partialSM(pB0, pB1, m_reg, mnB, alB);
  __syncthreads(); RESC(alB);
  finishSM(pB0, pB1, alB, l_reg, pa0, pa1, pa2, pa3); SBAR();
  pv_d0(o, vb0 + (int)SHM_V, pa0, pa1, pa2, pa3);
  if (hi == 0) li_l[r32] = l_reg; asm volatile("s_waitcnt lgkmcnt(0)" ::: "memory");
  float rli[16];
#pragma unroll
  for (int r = 0; r < 16; ++r) rli[r] = __builtin_amdgcn_rcpf(li_l[crow(r, hi)]);
  __syncthreads();
  { char* stg = lds + wid * 8192;
#pragma unroll
    for (int r = 0; r < 16; ++r) { const int orow = crow(r, hi);
#pragma unroll
      for (int d0 = 0; d0 < 4; ++d0) *(bf16_t*)(stg + orow * 256 + (d0 * 32 + r32) * 2) = (bf16_t)(cvtpk(o[d0][r] * rli[r], 0.f) & 0xffffu); }
    asm volatile("s_waitcnt lgkmcnt(0)" ::: "memory");
    int lane_ = lane; asm volatile("" : "+v"(lane_));
    const int rr = lane_ >> 4, ch = lane_ & 15;
#pragma unroll
    for (int i = 0; i < 8; ++i) { const int row = i * 4 + rr; const u32x4 ov = *(const u32x4*)(stg + row * 256 + ch * 16);
      const long gi = (long)(wid * QBLK + row) * LDO + ch * 8; const u32x4 z = *(const u32x4*)(ZAb + (long)(wid * QBLK + row) * LDZ + ch * 8); u32x4 w;
      w.x = cvtpk(bf_lo(ov.x) * bf_lo(z.x), bf_hi(ov.x) * bf_hi(z.x)); w.y = cvtpk(bf_lo(ov.y) * bf_lo(z.y), bf_hi(ov.y) * bf_hi(z.y));
      w.z = cvtpk(bf_lo(ov.z) * bf_lo(z.z), bf_hi(ov.z) * bf_hi(z.z)); w.w = cvtpk(bf_lo(ov.w) * bf_lo(z.w), bf_hi(ov.w) * bf_hi(z.w));
      *(u32x4*)(AAb + gi) = w; } }
#undef SLOAD
#undef SWRITE
#undef SWAIT
#undef RESC
}
#undef KSWZ
#undef SBAR
}


#define XB_TMO      128
#define XB_XCNT(j)  (256  + 64 * (j))
#define XB_XSUB(j)  (1280 + 64 * (j))
#define XB_XGEN(j)  (2304 + 64 * (j))
#define XB_TOP      3328
#define XB_TOPGEN   3392
#define XCD_BAR_WORDS 3456
#define XB_SPIN_CAP (1u << 18)
__device__ __forceinline__ unsigned xb_ld(unsigned* p)              { return __hip_atomic_load(p, __ATOMIC_RELAXED, __HIP_MEMORY_SCOPE_AGENT); }
__device__ __forceinline__ unsigned xb_add(unsigned* p, unsigned v) { return __hip_atomic_fetch_add(p, v, __ATOMIC_RELAXED, __HIP_MEMORY_SCOPE_AGENT); }
__device__ __forceinline__ unsigned xb_xcc_id() { return (unsigned)__builtin_amdgcn_s_getreg((3 << 11) | 20) & 0xFu; }
#define XB_SPIN(cond, bar) do { unsigned _sp = 0; while (cond) { __builtin_amdgcn_s_sleep(1); \
    if ((++_sp & 255u) == 0u) { if (xb_ld(&(bar)[XB_TMO])) break; if (_sp > XB_SPIN_CAP) { atomicAdd(&(bar)[XB_TMO], 1u); break; } } } } while (0)
struct XcdBarrier { unsigned* bar; unsigned x; volatile LAS unsigned* st; };
__device__ __forceinline__ XcdBarrier xcd_barrier_post(unsigned* bar, volatile LAS unsigned* st) {
    XcdBarrier b; b.bar = bar; b.x = xb_xcc_id(); b.st = st;
    if (threadIdx.x == 0) (void)xb_add(&bar[XB_XCNT(b.x)], 1u);
    return b;
}
__device__ __forceinline__ void xcd_barrier_complete(unsigned* bar, unsigned x, unsigned& nloc, unsigned& nx) {
    const unsigned G = gridDim.x * gridDim.y * gridDim.z;
    unsigned sum, cnt, mine, sp = 0u;
    for (;;) {
        sum = 0u; cnt = 0u; mine = 0u;
#pragma unroll
        for (unsigned j = 0; j < 16; ++j) { const unsigned c = xb_ld(&bar[XB_XCNT(j)]); sum += c; cnt += (c > 0u) ? 1u : 0u; mine = (j == x) ? c : mine; }
        if (sum == G) break;
        __builtin_amdgcn_s_sleep(1);
        if ((++sp & 255u) == 0u) { if (xb_ld(&bar[XB_TMO])) break; if (sp > XB_SPIN_CAP) { atomicAdd(&bar[XB_TMO], 1u); break; } }
    }
    nloc = mine > 0u ? mine : 1u; nx = cnt > 0u ? cnt : 1u;
}
__device__ __forceinline__ void xcd_barrier(const XcdBarrier& b) {
    asm volatile("s_waitcnt vmcnt(0)" ::: "memory");
    __syncthreads();
    if (threadIdx.x == 0) {
        unsigned* bar = b.bar;
        __builtin_amdgcn_s_waitcnt(0);
        unsigned nloc = b.st[0], nx = b.st[1];
        if (nloc == 0u) { xcd_barrier_complete(bar, b.x, nloc, nx); b.st[0] = nloc; b.st[1] = nx; }
        const unsigned old = xb_add(&bar[XB_XSUB(b.x)], 1u);
        const unsigned gen = old / nloc;
        if (old + 1u == (gen + 1u) * nloc) {
            __builtin_amdgcn_fence(__ATOMIC_RELEASE, "agent");
            asm volatile("s_waitcnt vmcnt(0)" ::: "memory");
            const unsigned og = xb_add(&bar[XB_TOP], 1u);
            const unsigned tg = og / nx;
            if (og + 1u == (tg + 1u) * nx) xb_add(&bar[XB_TOPGEN], 1u);
            else XB_SPIN(xb_ld(&bar[XB_TOPGEN]) == tg, bar);
            __builtin_amdgcn_fence(__ATOMIC_ACQUIRE, "agent");
            xb_add(&bar[XB_XGEN(b.x)], 1u);
            asm volatile("s_waitcnt vmcnt(0)" ::: "memory");
        } else {
            XB_SPIN(xb_ld(&bar[XB_XGEN(b.x)]) == gen, bar);
            __builtin_amdgcn_fence(__ATOMIC_ACQUIRE, "agent");
            asm volatile("s_waitcnt vmcnt(0)" ::: "memory");
        }
    }
    __syncthreads();
}

struct Args { const float* in[14]; float* out; unsigned char* ws; int ph_lo, ph_hi; };

__device__ __forceinline__ int winT_row(int n) {
    if (n < 2048) { const int hb = n & ~127, d = n & 127, axis = d >> 6, nn = (d >> 5) & 1, f = d & 31; const int wc = axis * 2 + (f >> 4), fq = (f >> 2) & 3, e = f & 3; return hb + wc * 32 + 8 * fq + 4 * nn + e; }
    if (n < 4096) return n;
    return n + 512;
}
template <bool PERMW>
__device__ __forceinline__ void p0_tr_load(const float* W, int N, int kb, int nb, int lane, f32x4 (&v)[8]) {
    const float* src = W + (size_t)(64 * kb + 8 * (lane & 7)) * N + 32 * nb + 4 * (lane >> 3);
#pragma unroll
    for (int e = 0; e < 8; ++e) v[e] = __builtin_nontemporal_load((const f32x4*)(src + (size_t)e * N));
}
template <bool PERMW>
__device__ __forceinline__ void p0_tr_store(bf16_t* WT, int K  , int kb, int nb, int lane, const f32x4 (&v)[8]) {
    const int kq = lane & 7, ng = lane >> 3;
#pragma unroll
    for (int j = 0; j < 4; ++j) { const int n = 32 * nb + 4 * ng + j, row = PERMW ? winT_row(n) : n;
        u32x4 o; o.x = cvt_pk_bf16(v[0][j], v[1][j]); o.y = cvt_pk_bf16(v[2][j], v[3][j]); o.z = cvt_pk_bf16(v[4][j], v[5][j]); o.w = cvt_pk_bf16(v[6][j], v[7][j]);
        *(u32x4*)(WT + (size_t)row * K + 64 * kb + 8 * kq) = o; }
}
struct TrItem { const float* W; bf16_t* WT; int K, N, kb, nb, perm; };
constexpr int TI_IN = 32 * 272, TI_PA = 24 * 64, TI_PB = 8 * 64, TI_O = 32 * 64, TI_L = TI_IN + TI_PA + TI_PB + TI_O;
__device__ __forceinline__ TrItem tr_decode(int it, const float* w_in, const float* w_pa, const float* w_pb, const float* w_out, unsigned char* ws) {
    TrItem t; const int l = it / TI_L; int r = it % TI_L;
    if (r < TI_IN) { const int kb = r / 272, nb0 = r % 272; t.W = w_in + (size_t)l * DM * INW; t.WT = (bf16_t*)(ws + WS_WIN + (size_t)l * 38 * MiB); t.K = DM; t.N = INW; t.kb = kb; t.nb = nb0 < 128 ? nb0 : nb0 + 16; t.perm = 1; return t; }
    r -= TI_IN;
    if (r < TI_PA) { t.W = w_pa + (size_t)l * 1536 * DM; t.WT = (bf16_t*)(ws + WS_WCAT + (size_t)l * 8 * MiB) + 512; t.K = DM; t.N = DM; t.kb = r / 64; t.nb = r % 64; t.perm = 0; return t; }
    r -= TI_PA;
    if (r < TI_PB) { t.W = w_pb + (size_t)l * 512 * DM; t.WT = (bf16_t*)(ws + WS_WCAT + (size_t)l * 8 * MiB); t.K = DM; t.N = DM; t.kb = r / 64; t.nb = r % 64; t.perm = 0; return t; }
    r -= TI_PB;
    t.W = w_out + (size_t)l * DM * DM; t.WT = (bf16_t*)(ws + WS_WO + (size_t)l * 8 * MiB); t.K = DM; t.N = DM; t.kb = r / 64; t.nb = r % 64; t.perm = 0; return t;
}

__global__ void __launch_bounds__(512, 2) mk_fwd(Args args) {
    extern __shared__ __attribute__((aligned(16))) unsigned char lds_raw[];
    LAS unsigned char* lds = (LAS unsigned char*)lds_raw;
    const int tid = threadIdx.x, lane = tid & 63, wave = __builtin_amdgcn_readfirstlane(tid >> 6);
    const int G = gridDim.x, cb = blockIdx.x;
    const int vcu = (G % 8 == 0) ? (cb % 8) * (G / 8) + cb / 8 : cb;
    unsigned char* ws = args.ws;
    const float *x = args.in[0], *cvec = args.in[1], *ctx = args.in[2], *c_ctx = args.in[3], *w_ada = args.in[4], *b_ada = args.in[5], *norm_g = args.in[6], *w_in = args.in[7],
                *q_norm_g = args.in[8], *k_norm_g = args.in[9], *w_pa = args.in[10], *w_pb = args.in[11], *w_out = args.in[12], *final_g = args.in[13];
    float* out = args.out;
    float* MOD = (float*)(ws + WS_MOD); float* ROPE = (float*)(ws + WS_TAB); bf16_t* DM256 = (bf16_t*)(ws + WS_TAB + 65536); bf16_t* DM2K = (bf16_t*)(ws + WS_DM);
    bf16_t *Hb = (bf16_t*)(ws + WS_H), *Qb = (bf16_t*)(ws + WS_Q), *Kb = (bf16_t*)(ws + WS_K), *Vb = (bf16_t*)(ws + WS_V), *ZA = (bf16_t*)(ws + WS_ZA), *ZB = (bf16_t*)(ws + WS_ZB),
           *GA = (bf16_t*)(ws + WS_GA), *GB = (bf16_t*)(ws + WS_GB), *UT = (bf16_t*)(ws + WS_UT), *UTC = (bf16_t*)(ws + WS_UTC), *ACAT = (bf16_t*)(ws + WS_ACAT), *MM = (bf16_t*)(ws + WS_MM);
    bf16_t* XS = (bf16_t*)(ws + WS_XS);
    const int lo = args.ph_lo, hi = args.ph_hi;
#ifndef PHMASK
#define PHMASK 0xffffu
#endif
#define PHON(k) (((PHMASK) >> ((k) > 5 && (k) < 11 ? (k) - 5 : (k))) & 1u)
#define IN(k) (PHON(k) && lo <= (k) && (k) < hi)
#if MK_XCD_BAR
    volatile LAS unsigned* MISC = (volatile LAS unsigned*)(lds + LDS_MISC);
    if (tid < 2) MISC[tid] = 0u;
    __syncthreads();
    XcdBarrier xbar; xbar.bar = (unsigned*)ws; xbar.x = 0; xbar.st = MISC;
    if (hi - lo > 1 && cb == 0) { for (int i = tid; i < 12288; i += 512) ((unsigned*)ws)[i] = 0u; }
#define SEAM(k) do { if (IN(k) && IN((k) + 1)) { if ((k) == 0) { cg::this_grid().sync(); xbar = xcd_barrier_post((unsigned*)ws, MISC); } else xcd_barrier(xbar); } } while (0)
#else
#define SEAM(k) do { if (IN(k) && IN((k) + 1)) { cg::this_grid().sync(); } } while (0)
#endif
    const int gw = vcu * 8 + wave, NGW = G * 8;

    for (int rep = 0; rep < NREP(0); ++rep)
    if (IN(0)) {
        const int tb0 = G == 256 ? 192 : 0, tbn = G - tb0;
        if (cb >= tb0) {
            LAS float* ctab = (LAS float*)lds;
            for (int i = tid; i < 2048; i += 512) ctab[i] = cospif((float)i * (1.f / 1024.f)) * 0.022097086912079608f;
            __syncthreads();
            for (int idx8 = (cb - tb0) * 512 + tid; idx8 < 2048 * 512; idx8 += tbn * 512) { const int n = idx8 >> 9, j0 = (idx8 & 511) * 8; float v[8];
#pragma unroll
                for (int e = 0; e < 8; ++e) { const int j = j0 + e; v[e] = j < 2048 ? ctab[(n * j) & 2047] : -ctab[(n * (j - 2048) - 512) & 2047]; }
                u32x4 o; o.x = cvt_pk_bf16(v[0], v[1]); o.y = cvt_pk_bf16(v[2], v[3]); o.z = cvt_pk_bf16(v[4], v[5]); o.w = cvt_pk_bf16(v[6], v[7]);
                *(u32x4*)(DM2K + (size_t)n * 4096 + j0) = o; }
            for (int idx8 = (cb - tb0) * 512 + tid; idx8 < 256 * 64; idx8 += tbn * 512) { const int n = idx8 >> 6, j0 = (idx8 & 63) * 8; float v[8];
#pragma unroll
                for (int e = 0; e < 8; ++e) { const int j = j0 + e; v[e] = 2.8284271247461903f * (j < 256 ? ctab[((n * j) & 255) * 8] : -ctab[((((n * (j - 256)) & 255) * 8) - 512) & 2047]); }
                u32x4 o; o.x = cvt_pk_bf16(v[0], v[1]); o.y = cvt_pk_bf16(v[2], v[3]); o.z = cvt_pk_bf16(v[4], v[5]); o.w = cvt_pk_bf16(v[6], v[7]);
                *(u32x4*)(DM256 + (size_t)n * 512 + j0) = o; }
            for (int idx = (cb - tb0) * 512 + tid; idx < 64 * 32; idx += tbn * 512) { const int pos = idx >> 5, f = idx & 31; const float inv = exp2f(-(float)f * (13.287712379549449f / 32.f)); const float ang = (float)pos * inv;
                ROPE[idx * 2] = cosf(ang); ROPE[idx * 2 + 1] = sinf(ang); }
            for (int idx8 = (cb - tb0) * 512 + tid; idx8 < 256 * 16; idx8 += tbn * 512) { const int jp = idx8 >> 4, c0 = (idx8 & 15) * 8, cp = jp & 127; float v[8];
#pragma unroll
                for (int e = 0; e < 8; ++e) { const float ph = (float)(((c0 + e) * cp) & 127) * (1.f / 64.f); v[e] = (jp < 128 ? cospif(ph) : sinpif(ph)) * 0.08838834764831845f; }
                u32x4 o; o.x = cvt_pk_bf16(v[0], v[1]); o.y = cvt_pk_bf16(v[2], v[3]); o.z = cvt_pk_bf16(v[4], v[5]); o.w = cvt_pk_bf16(v[6], v[7]);
                *(u32x4*)((bf16_t*)(ws + WS_TT) + jp * 128 + c0) = o; }
            __syncthreads();
        }
        {
            LAS float* sc = (LAS float*)lds;
            LAS float* part = (LAS float*)(lds + 40960);
            for (int idx = tid; idx < 5 * 2048; idx += 512) { const int r = idx >> 11, k = idx & 2047; const float v = r < 4 ? cvec[r * 2048 + k] : c_ctx[k]; sc[idx] = v * sigmoidf_(v); }
            __syncthreads();
            for (int item = cb; item < 192; item += G) {
                const int l = item / 96, cc = item % 96, cg4 = lane & 15, kp = lane >> 4;
                const float* wp = w_ada + ((size_t)l * 2048 + wave * 256 + kp) * 6144 + cc * 64 + cg4 * 4;
                f32x4 a0 = {0.f, 0.f, 0.f, 0.f}, a1 = a0, a2 = a0, a3 = a0, a4 = a0;
#pragma unroll 8
                for (int i = 0; i < 64; ++i) { const f32x4 w = *(const f32x4*)(wp + (size_t)i * 4 * 6144); const int k = wave * 256 + 4 * i + kp;
                    a0 += w * sc[k]; a1 += w * sc[2048 + k]; a2 += w * sc[4096 + k]; a3 += w * sc[6144 + k]; a4 += w * sc[8192 + k]; }
#pragma unroll
                for (int e = 0; e < 4; ++e) { a0[e] += __shfl_xor(a0[e], 16); a0[e] += __shfl_xor(a0[e], 32); a1[e] += __shfl_xor(a1[e], 16); a1[e] += __shfl_xor(a1[e], 32);
                    a2[e] += __shfl_xor(a2[e], 16); a2[e] += __shfl_xor(a2[e], 32); a3[e] += __shfl_xor(a3[e], 16); a3[e] += __shfl_xor(a3[e], 32); a4[e] += __shfl_xor(a4[e], 16); a4[e] += __shfl_xor(a4[e], 32); }
                if (kp == 0) { LAS float* pp = part + wave * 320 + cg4 * 4;
                    *(LAS f32x4*)(pp) = a0; *(LAS f32x4*)(pp + 64) = a1; *(LAS f32x4*)(pp + 128) = a2; *(LAS f32x4*)(pp + 192) = a3; *(LAS f32x4*)(pp + 256) = a4; }
                __syncthreads();
                if (tid < 320) { const int r = tid >> 6, j = tid & 63; float s = b_ada[l * 6144 + cc * 64 + j];
#pragma unroll
                    for (int w = 0; w < 8; ++w) s += part[w * 320 + r * 64 + j];
                    MOD[((size_t)l * 5 + r) * 6144 + cc * 64 + j] = s; }
                __syncthreads();
            }
            __syncthreads();
        }
        {
            for (int it = gw; it < 2 * TI_L; it += 2 * NGW) {
                const TrItem t0 = tr_decode(it, w_in, w_pa, w_pb, w_out, ws); const bool two = it + NGW < 2 * TI_L;
                const TrItem t1 = tr_decode(two ? it + NGW : it, w_in, w_pa, w_pb, w_out, ws);
                f32x4 v0[8], v1[8];
                p0_tr_load<false>(t0.W, t0.N, t0.kb, t0.nb, lane, v0);
                if (two) p0_tr_load<false>(t1.W, t1.N, t1.kb, t1.nb, lane, v1);
                if (t0.perm) p0_tr_store<true>(t0.WT, t0.K, t0.kb, t0.nb, lane, v0); else p0_tr_store<false>(t0.WT, t0.K, t0.kb, t0.nb, lane, v0);
                if (two) { if (t1.perm) p0_tr_store<true>(t1.WT, t1.K, t1.kb, t1.nb, lane, v1); else p0_tr_store<false>(t1.WT, t1.K, t1.kb, t1.nb, lane, v1); }
            }
            __syncthreads();
        }
        {
            bf16_t* WUB = (bf16_t*)(ws + WS_WUB);
            for (int idx8 = cb * 512 + tid; idx8 < 2 * 4 * 2048 * 16; idx8 += G * 512) { const int e = idx8 * 8, c0 = e & 127, k = (e >> 7) & 2047, g = (e >> 18) & 3, l2 = e >> 20;
                const float* src = w_in + ((size_t)l2 * DM + k) * INW + 4096 + g * 128 + c0; const f32x4 a = *(const f32x4*)src, b = *(const f32x4*)(src + 4);
                u32x4 o; o.x = cvt_pk_bf16(a[0], a[1]); o.y = cvt_pk_bf16(a[2], a[3]); o.z = cvt_pk_bf16(b[0], b[1]); o.w = cvt_pk_bf16(b[2], b[3]);
                *(u32x4*)(WUB + e) = o; }
        }
    }
    SEAM(0);

    const bool handoff = (G == 256 && hi - lo > 1);
    const bool fuse_final = (G == 256 && hi - lo > 1);
    for (int l = 0; l < 2; ++l) {
        const int P = 1 + 5 * l;
        const float* modl = MOD + (size_t)l * 5 * 6144;
        const int nM = l == 0 ? 36 : 32;
        for (int rep = 0; rep < NREP(P + 0); ++rep)
        if (IN(P)) {
            int lane = tid & 63; asm volatile("" : "+v"(lane));
            const float* xs = x; const float* cs = ctx; const float* PART = (const float*)(ws + WS_PART); const float* gn = norm_g + l * DM;
            const bool foldcu = (l == 0 && G == 256);
            const int r0 = foldcu ? (vcu >= 64 ? (vcu - 64) * 8 + wave : MT) : gw, rstep = foldcu ? 192 * 8 : NGW;
            const bool nbal = (l == 1 && G == 256);
            const int kmax = nbal ? 5 : (r0 < MT ? (MT - r0 + rstep - 1) / rstep : 0);
            for (int k = 0; k < kmax; ++k) {
                int r;
                if (nbal) { if (gw < 1024) { if (k == 4) continue; r = k == 0 ? ML + gw : gw + (k - 1) * 1024; } else r = 3072 + (gw - 1024) + k * 1024; }
                else r = r0 + k * rstep;
                const float* src = r < ML ? xs + (size_t)r * DM : cs + (size_t)(r - ML) * DM;
                const float* mrow = modl + (size_t)(r < ML ? (r >> 11) : 4) * 6144;
                f32x4 v[8]; float ss = 0.f;
#pragma unroll
                for (int j = 0; j < 8; ++j) v[j] = (f32x4){0.f, 0.f, 0.f, 0.f};
                if (!(l == 1 && r < ML)) {
#pragma unroll
                    for (int j = 0; j < 8; ++j) v[j] = *(const f32x4*)(src + j * 256 + lane * 4); }
                else {
#pragma unroll
                    for (int j = 0; j < 8; ++j) { const u32x2 q = *(const u32x2*)(XS + (size_t)r * DM + j * 256 + lane * 4); v[j] = (f32x4){bf_lo(q.x), bf_hi(q.x), bf_lo(q.y), bf_hi(q.y)}; } }
                if (l == 1 && r >= ML) {
                    const float* pp = PART + (size_t)(r - ML) * DM + lane * 4;
#pragma unroll
                    for (int ch = 0; ch < 4; ++ch)
#pragma unroll
                        for (int j = 0; j < 8; ++j) v[j] += *(const f32x4*)(pp + (size_t)ch * MC * DM + j * 256); }
#pragma unroll
                for (int j = 0; j < 8; ++j) ss += (v[j][0] * v[j][0] + v[j][1] * v[j][1]) + (v[j][2] * v[j][2] + v[j][3] * v[j][3]);
                const float rstd = __builtin_amdgcn_rsqf(wave_sum(ss) * (1.f / DM) + EPS);
#pragma unroll
                for (int j = 0; j < 8; ++j) { const int col = j * 256 + lane * 4; const f32x4 g = *(const f32x4*)(gn + col), sh = *(const f32x4*)(mrow + col), sl = *(const f32x4*)(mrow + 2048 + col);
                    const f32x4 h = (v[j] * rstd * g) * (sl + 1.f) + sh; u32x2 w; w.x = cvt_pk_bf16(h[0], h[1]); w.y = cvt_pk_bf16(h[2], h[3]);
                    *(u32x2*)(Hb + (size_t)r * DM + col) = w; }
            }
            if (l == 0) {
                __syncthreads();
                FoldSched S; S.G = G; S.c = vcu; S.Tt = (const char*)(ws + WS_TT); S.Wub = (const char*)(ws + WS_WUB);
                FoldEpi E; E.ws = ws; pg8::gemm_phase(lds, 128, S, E);
            }
        }
        SEAM(P);
        for (int rep = 0; rep < NREP(P + 1); ++rep)
        if (IN(P + 1)) {
            G1Sched S; S.Gq = G; S.cq = cb; S.nM = nM; S.nA = nM * 18; S.n1 = 4 * nM; S.n2 = l == 0 ? 0 : 16; S.Lbase = 0;
            S.split = (l == 0 && G == 256) ? 1 : 0;
            { const int tot = S.nA + S.n1 + S.n2 + nM * 16; S.Lend = (l == 0 && G == 256) ? 1280 : tot; }
            S.H = (const char*)Hb; S.W = (const char*)(ws + WS_WIN + (size_t)l * 38 * MiB);
            G1Epi E; E.ws = ws; E.qg = q_norm_g + l * 128; E.kg = k_norm_g + l * 128; E.X = (LAS float*)(lds + LDS_X);
            pg8::gemm_phase(lds, DM, S, E);
        }
        SEAM(P + 1);
        for (int rep = 0; rep < NREP(P + 2); ++rep)
        if (IN(P + 2)) {
            const int nun = l == 0 ? 384 + 48 : 384;
#ifndef NO_ATT
            const int astride = (l == 1 && G == 256) ? 192 : G;
            const bool ctxm1 = (l == 0 && G == 256 && hi - lo > 1);
            const int nk = ctxm1 ? 3 : (nun + astride - 1) / astride + 1;
            for (int k = 0; k < nk; ++k) {
                int a;
                if (ctxm1) a = (k == 0) ? (vcu < 48 ? 384 + vcu : -1) : (vcu + (k - 1) * 256 < 384 ? vcu + (k - 1) * 256 : -1);
                else { a = vcu < astride ? vcu + k * astride : -1; if (a >= nun) a = -1; }
                if (a < 0) continue;
                __syncthreads();
                size_t qo, ko, ao; int seq;
                if (a < 384) { const int bk = a / 24, hq = (a % 24) >> 3, qb = a & 7, b = bk >> 2, kvh = bk & 3, h = kvh * 3 + hq;
                    qo = ((size_t)b * SEQ + qb * 256) * 1536 + h * 128; ao = ((size_t)b * SEQ + qb * 256) * DM + 512 + h * 128; ko = (size_t)b * KEYS * 512 + kvh * 128; seq = KEYS;
                } else { const int a2 = a - 384, b = a2 / 12, h = a2 % 12, kvh = h / 3;
                    qo = ((size_t)ML + b * CTX) * 1536 + h * 128; ao = ((size_t)ML + b * CTX) * DM + 512 + h * 128; ko = ((size_t)b * KEYS + SEQ) * 512 + kvh * 128; seq = CTX; }
                qo = ufl64(qo); ko = ufl64(ko); ao = ufl64(ao); seq = ufl(seq);
                att::attn_dense_body(Qb + qo, Kb + ko, Vb + ko, ZA + qo, ACAT + ao, seq, (char*)lds_raw);
                if (ctxm1 && a >= 384) {
                    asm volatile("s_waitcnt vmcnt(0)" ::: "memory"); __syncthreads();
                    if (tid == 0) { __builtin_amdgcn_fence(__ATOMIC_RELEASE, "agent"); asm volatile("s_waitcnt vmcnt(0)" ::: "memory");
                        (void)__hip_atomic_fetch_add((unsigned*)ws + CW_CTXCNT, 1u, __ATOMIC_RELAXED, __HIP_MEMORY_SCOPE_AGENT); }
                }
            }
#endif
            __syncthreads();
#ifndef NO_FN
            { FnSched S; S.G = G; S.c = vcu; S.cu0 = G >= 256 ? 192 : 0; S.nunits = 64; S.ntn = 8; S.nt = 64; S.A = (const char*)DM2K; S.B = (const char*)UT; S.astep = 2 * MiB; S.bstep = 2 * MiB; S.bbatch = 4 * MiB; S.row_base = 0; S.rows_per_b = SEQ;
              FnEpi E; E.ACAT = ACAT; E.ZB = ZB; pg8::gemm_phase(lds, 4096, S, E); }
            if (l == 0) { FnSched S; S.G = G; S.c = vcu; S.cu0 = G >= 256 ? 176 : 0; S.nunits = 8; S.ntn = 1; S.nt = 8; S.A = (const char*)DM256; S.B = (const char*)UTC; S.astep = 0; S.bstep = MiB / 4; S.bbatch = MiB / 2; S.row_base = ML; S.rows_per_b = CTX;
              FnEpi E; E.ACAT = ACAT; E.ZB = ZB; pg8::gemm_phase(lds, 512, S, E); }
#endif
            if (ctxm1 && vcu >= 176 && vcu < 184) {
                asm volatile("s_waitcnt vmcnt(0)" ::: "memory"); __syncthreads();
                if (tid == 0) { __builtin_amdgcn_fence(__ATOMIC_RELEASE, "agent"); asm volatile("s_waitcnt vmcnt(0)" ::: "memory");
                    (void)__hip_atomic_fetch_add((unsigned*)ws + CW_CTXCNT, 1u, __ATOMIC_RELAXED, __HIP_MEMORY_SCOPE_AGENT); }
            }
            if (l == 0 && G == 256) {
                G1Sched S; S.Gq = 64; S.cq = (vcu >= 160 && vcu < 176) ? vcu - 160 : (vcu >= 184 && vcu < 192) ? 16 + vcu - 184 : (vcu >= 128 && vcu < 160) ? 24 + vcu - 128 : (vcu >= 176 && vcu < 184) ? 56 + vcu - 176 : -1; S.nM = nM; S.nA = nM * 18; S.n1 = 4 * nM; S.n2 = 0; S.Lbase = 1280; S.Lend = S.nA + S.n1 + nM * 16; S.split = 1;
                S.H = (const char*)Hb; S.W = (const char*)(ws + WS_WIN);
                G1Epi E; E.ws = ws; E.qg = q_norm_g; E.kg = k_norm_g; E.X = (LAS float*)(lds + LDS_X);
                pg8::gemm_phase(lds, DM, S, E);
            }
            if (ctxm1 && vcu >= 128 && vcu < 160) {
                if (tid == 0) { unsigned sp = 0;
                    while (__hip_atomic_load((unsigned*)ws + CW_CTXCNT, __ATOMIC_RELAXED, __HIP_MEMORY_SCOPE_AGENT) < 56u) { __builtin_amdgcn_s_sleep(2); if (++sp > (1u << 22)) break; }
                    __builtin_amdgcn_fence(__ATOMIC_ACQUIRE, "agent"); asm volatile("s_waitcnt vmcnt(0)" ::: "memory"); }
                __syncthreads();
                CtxM1Sched S; S.cq = vcu - 128; S.A = (const char*)ACAT; S.B = (const char*)(ws + WS_WCAT);
                M1Epi E; E.MMo = MM; E.GA = GA; E.GB = GB; pg8::gemm_phase(lds, DM, S, E);
            }
        }
        SEAM(P + 2);
        for (int rep = 0; rep < NREP(P + 3); ++rep)
        if (IN(P + 3)) {
            M1Sched S; S.G = G; S.c = cb; S.nM = (l == 0 && G == 256 && hi - lo > 1) ? 32 : nM; S.A = (const char*)ACAT; S.B = (const char*)(ws + WS_WCAT + (size_t)l * 8 * MiB);
            M1Epi E; E.MMo = MM; E.GA = GA; E.GB = GB; pg8::gemm_phase(lds, DM, S, E);
            if (handoff) {
                int pm_, pn_; pg8::tile_decode(cb, 32, 8, pm_, pn_); pm_ = ufl(pm_);
                asm volatile("s_waitcnt vmcnt(0)" ::: "memory"); __syncthreads();
                if (tid == 0) { __builtin_amdgcn_fence(__ATOMIC_RELEASE, "agent"); asm volatile("s_waitcnt vmcnt(0)" ::: "memory");
                    (void)__hip_atomic_fetch_add((unsigned*)ws + 6144 + 64 * (l * 32 + pm_), 1u, __ATOMIC_RELAXED, __HIP_MEMORY_SCOPE_AGENT); }
            }
        }
        if (!handoff) SEAM(P + 3);
        for (int rep = 0; rep < NREP(P + 4); ++rep)
        if (IN(P + 4)) {
            if (handoff) {
                int pm_, pn_; pg8::tile_decode(cb, 32, 8, pm_, pn_); pm_ = ufl(pm_);
                if (tid == 0) { unsigned sp = 0;
                    while (__hip_atomic_load((unsigned*)ws + 6144 + 64 * (l * 32 + pm_), __ATOMIC_RELAXED, __HIP_MEMORY_SCOPE_AGENT) < 8u) { __builtin_amdgcn_s_sleep(1); if (++sp > (1u << 22)) break; }
                    __builtin_amdgcn_fence(__ATOMIC_ACQUIRE, "agent"); asm volatile("s_waitcnt vmcnt(0)" ::: "memory"); }
                __syncthreads();
            }
            OSched S; S.G = G; S.c = cb; S.nctx = l == 0 ? 128 : 0; S.A = (const char*)MM; S.B = (const char*)(ws + WS_WO + (size_t)l * 8 * MiB);
            ResEpi E; E.out = XS; E.xin = l == 0 ? (const void*)x : (const void*)XS; E.in_bf = l; E.cs_out = (float*)(ws + WS_PART); E.gate = modl + 4096; E.fuse = (l == 1 && fuse_final) ? 1 : 0; E.fout = out; E.fg = final_g; E.ctl = ws; E.PL = (LAS float*)(lds + LDS_X); pg8::gemm_phase(lds, DM, S, E);
        }
        if (!(l == 1 && fuse_final)) SEAM(P + 4);
    }
    if (IN(11) && !fuse_final) {
        for (int r = gw; r < ML; r += NGW) {
            float* src = out + (size_t)r * DM; f32x4 v[8]; float ss = 0.f;
#pragma unroll
            for (int j = 0; j < 8; ++j) { const u32x2 q = *(const u32x2*)(XS + (size_t)r * DM + j * 256 + lane * 4); v[j] = (f32x4){bf_lo(q.x), bf_hi(q.x), bf_lo(q.y), bf_hi(q.y)};
                ss += (v[j][0] * v[j][0] + v[j][1] * v[j][1]) + (v[j][2] * v[j][2] + v[j][3] * v[j][3]); }
            const float rstd = __builtin_amdgcn_rsqf(wave_sum(ss) * (1.f / DM) + EPS);
#pragma unroll
            for (int j = 0; j < 8; ++j) { const int col = j * 256 + lane * 4; const f32x4 g = *(const f32x4*)(final_g + col); f32x4 o = v[j] * rstd * g;
                *(f32x4*)(src + col) = o; }
        }
    }
#undef IN
#undef SEAM
}

extern "C" void kernel_launch(void* const* d_in, const int* in_sizes, int n_in, void* d_out, int out_size, void* d_ws, size_t ws_size, hipStream_t stream) {
    static int grid = 0;
    if (grid == 0) {
        if (n_in != 14 || in_sizes[0] != ML * DM || out_size != ML * DM || ws_size < WS_END) { fprintf(stderr, "kernel_launch: unexpected shapes (n_in %d, in0 %d, out %d, ws %zu < %zu)\n", n_in, n_in > 0 ? in_sizes[0] : -1, out_size, ws_size, (size_t)WS_END); grid = -1; return; }
        int dev = 0, cus = 0, per_cu = 0;
        hipGetDevice(&dev); hipDeviceGetAttribute(&cus, hipDeviceAttributeMultiprocessorCount, dev);
        if (hipFuncSetAttribute((const void*)mk_fwd, hipFuncAttributeMaxDynamicSharedMemorySize, LDS_BYTES) != hipSuccess) { fprintf(stderr, "kernel_launch: hipFuncSetAttribute failed\n"); grid = -1; return; }
        if (hipOccupancyMaxActiveBlocksPerMultiprocessor(&per_cu, (const void*)mk_fwd, 512, LDS_BYTES) != hipSuccess || per_cu < 1) { fprintf(stderr, "kernel_launch: occupancy query says %d\n", per_cu); per_cu = 1; }
        (void)hipGetLastError();
        grid = cus > 0 ? cus : 256;
    }
    if (grid < 0) return;
    Args a{};
    for (int i = 0; i < 14; ++i) a.in[i] = (const float*)d_in[i];
    a.out = (float*)d_out; a.ws = (unsigned char*)d_ws;
#if MK_ONE_LAUNCH
    a.ph_lo = 0; a.ph_hi = NPH;
    void* kargs[] = {&a};
    hipError_t e = hipLaunchCooperativeKernel((const void*)mk_fwd, dim3(grid), dim3(512), kargs, LDS_BYTES, stream);
    if (e != hipSuccess) fprintf(stderr, "kernel_launch: cooperative launch failed: %s (grid %d)\n", hipGetErrorString(e), grid);
#else
    for (int p = 0; p < NPH; ++p) {
        a.ph_lo = p; a.ph_hi = p + 1;
        hipLaunchKernelGGL(mk_fwd, dim3(grid), dim3(512), LDS_BYTES, stream, a);
    }
    hipError_t e = hipPeekAtLastError();
    if (e != hipSuccess) fprintf(stderr, "kernel_launch: launch failed: %s\n", hipGetErrorName(e));
#endif
}
```

```cpp
#include <hip/hip_runtime.h>
#include <hip/hip_cooperative_groups.h>
#include <cstdio>
#include <cstdint>
namespace cg = cooperative_groups;

#ifndef MK_ONE_LAUNCH
#define MK_ONE_LAUNCH 1
#endif
#ifndef MK_XCD_BAR
#define MK_XCD_BAR 1
#endif
#ifndef PROBE_REP
#define PROBE_REP (-1)
#endif
#define NREP(k) ((k) == PROBE_REP ? 2 : 1)


#define LAS __attribute__((address_space(3)))
typedef unsigned short bf16_t;
typedef short bf16x8 __attribute__((ext_vector_type(8)));
typedef short s16x4 __attribute__((ext_vector_type(4)));
typedef float f32x4 __attribute__((ext_vector_type(4)));
typedef float f32x16 __attribute__((ext_vector_type(16)));
typedef unsigned u32x4 __attribute__((ext_vector_type(4)));
typedef unsigned u32x2 __attribute__((ext_vector_type(2)));

constexpr int DM = 2048, NB = 4, SEQ = 2048, CTX = 256;
constexpr int ML = NB * SEQ, MC = NB * CTX, MT = ML + MC;
constexpr int INW = 9216, KEYS = SEQ + CTX;
constexpr int NPH = 12;
constexpr float EPS = 1e-6f;

constexpr size_t MiB = 1u << 20;
constexpr size_t WS_MOD = 1 * MiB;
constexpr size_t WS_TAB = 2 * MiB;
constexpr size_t WS_TT = 2 * MiB + 512 * 1024;
constexpr size_t WS_DM = 3 * MiB;
constexpr size_t WS_WIN = 19 * MiB;
constexpr size_t WS_WCAT = 95 * MiB;
constexpr size_t WS_WO = 111 * MiB;
constexpr size_t WS_H = 127 * MiB;
constexpr size_t WS_Q = 163 * MiB;
constexpr size_t WS_K = 190 * MiB;
constexpr size_t WS_V = 199 * MiB;
constexpr size_t WS_ZA = 208 * MiB;
constexpr size_t WS_ZB = 235 * MiB;
constexpr size_t WS_GA = 244 * MiB;
constexpr size_t WS_GB = 280 * MiB;
constexpr size_t WS_UT = 316 * MiB;
constexpr size_t WS_UTC = 332 * MiB;
constexpr size_t WS_WUB = 334 * MiB;
constexpr size_t WS_XS = 338 * MiB;
constexpr size_t WS_AA = 338 * MiB;
constexpr size_t WS_AB = 361 * MiB;
constexpr size_t WS_ACAT = 370 * MiB;
constexpr size_t WS_MM = 406 * MiB;
constexpr size_t WS_CS1 = 442 * MiB;
constexpr size_t WS_PART = 450 * MiB;
constexpr size_t WS_END = 514 * MiB;

constexpr int LDS_BYTES = 147456;
constexpr int LDS_X = 131072;
constexpr int LDS_MISC = 131072 + 8192;
constexpr int CW_CTXCNT = 3520;
constexpr size_t CTL_ZERO_BYTES = 16384;

__device__ __forceinline__ unsigned cvt_pk_bf16(float lo, float hi) { unsigned r; asm volatile("v_cvt_pk_bf16_f32 %0, %1, %2" : "=v"(r) : "v"(lo), "v"(hi)); return r; }
__device__ __forceinline__ float bf_lo(unsigned w) { return __uint_as_float(w << 16); }
__device__ __forceinline__ float bf_hi(unsigned w) { return __uint_as_float(w & 0xffff0000u); }
__device__ __forceinline__ float bf2f(bf16_t v) { return __uint_as_float((unsigned)v << 16); }
__device__ __forceinline__ unsigned f2bf(float f) { unsigned u = __builtin_bit_cast(unsigned, f); return (u + 0x7fffu + ((u >> 16) & 1u)) >> 16; }
__device__ __forceinline__ float sigmoidf_(float x) { return __builtin_amdgcn_rcpf(1.f + __builtin_amdgcn_exp2f(-1.4426950408889634f * x)); }
__device__ __forceinline__ int ufl(int v) { return __builtin_amdgcn_readfirstlane(v); }
__device__ __forceinline__ size_t ufl64(size_t v) { const unsigned lo = __builtin_amdgcn_readfirstlane((unsigned)v), hi = __builtin_amdgcn_readfirstlane((unsigned)(v >> 32)); return ((size_t)hi << 32) | lo; }
__device__ __forceinline__ float wave_sum(float v) {
#pragma unroll
    for (int o = 1; o < 64; o <<= 1) v += __shfl_xor(v, o);
    return v;
}

namespace pg8 {
constexpr int BM = 256, BK = 64, HALF = 128, HTB = HALF * BK * 2, STAGE_BYTES = 8 * HTB;
__host__ __device__ __forceinline__ int lds_byte(int r, int c) { const int st = (r >> 4) * 2 + (c >> 5), rr = r & 15, cc = c & 31, ob = rr * 64 + cc * 2; return st * 1024 + (ob ^ (((ob >> 9) & 1) << 5)); }
__host__ __device__ __forceinline__ void stage_rc(int b, int& R, int& C) { const int st = b / 1024, sb = b % 1024, swz = sb ^ (((sb >> 9) & 1) << 5); R = (st >> 1) * 16 + swz / 64; C = (st & 1) * 32 + (swz % 64) / 2; }
__host__ __device__ __forceinline__ int perm32(int rho) { const int n = rho >> 4, i = rho & 15; return 8 * (i >> 2) + 4 * n + (i & 3); }

struct Unit { int kind, pm, pn, nt, keep; const char* a; const char* b; };

__device__ __forceinline__ void tile_decode(int L, int nM, int nN, int& pm, int& pn) {
    const int nwg = nM * nN; int wgid = L;
    { const int q = nwg / 8, r = nwg % 8, xcd = wgid % 8, off = wgid / 8; wgid = (xcd < r ? xcd * (q + 1) : r * (q + 1) + (xcd - r) * q) + off; }
    const int nig = 8 * nN, gid = wgid / nig, fm = gid * 8, gsz = (nM - fm) < 8 ? (nM - fm) : 8;
    pm = fm + ((wgid % nig) % gsz); pn = (wgid % nig) / gsz;
}

template <class Epi, class Sched>
__device__ __forceinline__ void gemm_phase(LAS unsigned char* lds, const int K, const Sched& S, const Epi& E) {
    int tid = threadIdx.x; asm volatile("" : "+v"(tid));
    const int wid = __builtin_amdgcn_readfirstlane(tid >> 6), lane = tid & 63, wr = wid >> 2, wc = wid & 3, fr = lane & 15, fq = lane >> 4;
    unsigned voffA[2], voffB[2];
#pragma unroll
    for (int i = 0; i < 2; ++i) { int R, C; stage_rc(tid * 16 + i * 8192, R, C); const int Rb = (R & ~31) + perm32(R & 31);
        voffA[i] = (unsigned)(R * K + C) * 2u; voffB[i] = (unsigned)(Rb * K + C) * 2u; }
    const size_t kstep = (size_t)(BK * 2);
    const size_t hstep = (size_t)HALF * K * 2;
    const unsigned ldsw = (unsigned)wid * 1024u;
    const int aoff = lds_byte(wr * 64 + fr, fq * 8), boff = lds_byte(wc * 32 + fr, fq * 8);
#define PG8_SA(b, h) (((b) * 2 + (h)) * HTB)
#define PG8_SB(b, h) ((4 + (b) * 2 + (h)) * HTB)
#define PG8_STAGE(bufoff, gbase, voff) do { _Pragma("unroll") for (int _i = 0; _i < 2; ++_i) \
        __builtin_amdgcn_global_load_lds((const unsigned*)((const char*)(gbase) + (voff)[_i]), (LAS unsigned*)(lds + (bufoff) + ldsw + _i * 8192), 16, 0, 0); } while (0)
#define PG8_LDA(dst, b, h) do { _Pragma("unroll") for (int m = 0; m < 4; ++m) _Pragma("unroll") for (int k = 0; k < 2; ++k) dst[m][k] = *(const LAS bf16x8*)(lds + PG8_SA(b, h) + aoff + m * 2048 + k * 1024); } while (0)
#define PG8_LDB(dst, b, h) do { _Pragma("unroll") for (int n = 0; n < 2; ++n) _Pragma("unroll") for (int k = 0; k < 2; ++k) dst[n][k] = *(const LAS bf16x8*)(lds + PG8_SB(b, h) + boff + n * 2048 + k * 1024); } while (0)
#define PG8_MMA(ai, bj, At, Bt) do { __builtin_amdgcn_s_setprio(1); _Pragma("unroll") for (int m = 0; m < 4; ++m) _Pragma("unroll") for (int n = 0; n < 2; ++n) _Pragma("unroll") for (int k = 0; k < 2; ++k) \
        acc[ai][bj][m][n] = __builtin_amdgcn_mfma_f32_16x16x32_bf16(Bt[n][k], At[m][k], acc[ai][bj][m][n], 0, 0, 0); __builtin_amdgcn_s_setprio(0); } while (0)
#define PG8_WAIT_V(n) asm volatile("s_waitcnt vmcnt(" #n ")" ::: "memory")
#define PG8_WAIT_L(n) asm volatile("s_waitcnt lgkmcnt(" #n ")" ::: "memory")
#define PG8_BAR __builtin_amdgcn_s_barrier()
#define PG8_SCHED __builtin_amdgcn_sched_barrier(0)
    Unit cur, nxt; int ui = 0; cur.keep = 0;
    if (!S.next(0, cur)) return;
    f32x4 acc[2][2][4][2];
#pragma unroll
    for (int a = 0; a < 2; ++a)
#pragma unroll
        for (int b = 0; b < 2; ++b)
#pragma unroll
            for (int m = 0; m < 4; ++m)
#pragma unroll
                for (int n = 0; n < 2; ++n) acc[a][b][m][n] = (f32x4){0.f, 0.f, 0.f, 0.f};
    bf16x8 At[4][2], B0[2][2], B1[2][2];
    const char* cA = cur.a; const char* cB = cur.b;
    PG8_STAGE(PG8_SB(0, 0), cB, voffB); PG8_STAGE(PG8_SB(0, 1), cB + hstep, voffB); PG8_STAGE(PG8_SA(0, 0), cA, voffA); PG8_STAGE(PG8_SA(0, 1), cA + hstep, voffA);
    if (wr == 1) PG8_BAR;
    PG8_WAIT_V(2); PG8_BAR;
    PG8_STAGE(PG8_SB(1, 0), cB + kstep, voffB); PG8_STAGE(PG8_SA(1, 0), cA + kstep, voffA); PG8_STAGE(PG8_SB(1, 1), cB + hstep + kstep, voffB);
    PG8_WAIT_V(6); PG8_BAR;
    for (;;) {
        nxt.keep = 0;
        const bool has_next = S.next(ui + 1, nxt);
        const char* nA = has_next ? nxt.a : cA; const char* nB = has_next ? nxt.b : cB;
        const int nt = cur.nt;
        for (int t = 0; t < nt; t += 2) {
            if constexpr (Epi::HAS_MID) { if (t == Epi::MID_T) E.mid(acc, cur, wr, wc, fr, fq); }
            const bool last = (t == nt - 2);
            const char* a1 = cA + (size_t)(t + 1) * kstep;
            const char* a2 = last ? nA : cA + (size_t)(t + 2) * kstep; const char* b2 = last ? nB : cB + (size_t)(t + 2) * kstep;
            const char* a3 = a2 + kstep; const char* b3 = b2 + kstep;
            PG8_LDB(B0, 0, 0); PG8_LDB(B1, 0, 1); PG8_SCHED; PG8_LDA(At, 0, 0); PG8_STAGE(PG8_SA(1, 1), a1 + hstep, voffA);
            PG8_WAIT_V(8); PG8_WAIT_L(0); PG8_BAR; PG8_MMA(0, 0, At, B0); PG8_MMA(0, 1, At, B1); PG8_BAR; PG8_SCHED;
            PG8_LDA(At, 0, 1); PG8_STAGE(PG8_SB(0, 0), b2, voffB); PG8_STAGE(PG8_SB(0, 1), b2 + hstep, voffB); PG8_STAGE(PG8_SA(0, 0), a2, voffA);
            PG8_WAIT_V(8); PG8_WAIT_L(0); PG8_BAR; PG8_MMA(1, 0, At, B0); PG8_MMA(1, 1, At, B1); PG8_BAR; PG8_SCHED;
            PG8_LDB(B0, 1, 0); PG8_LDB(B1, 1, 1); PG8_SCHED; PG8_LDA(At, 1, 0); PG8_STAGE(PG8_SA(0, 1), a2 + hstep, voffA);
            PG8_WAIT_V(8); PG8_WAIT_L(0); PG8_BAR; PG8_MMA(0, 0, At, B0); PG8_MMA(0, 1, At, B1); PG8_BAR; PG8_SCHED;
            PG8_LDA(At, 1, 1); PG8_STAGE(PG8_SB(1, 0), b3, voffB); PG8_STAGE(PG8_SB(1, 1), b3 + hstep, voffB); PG8_STAGE(PG8_SA(1, 0), a3, voffA);
            PG8_WAIT_V(8); PG8_WAIT_L(0); PG8_BAR; PG8_MMA(1, 0, At, B0); PG8_MMA(1, 1, At, B1); PG8_BAR; PG8_SCHED;
        }
        if (wr == 0) PG8_BAR;
        E(acc, cur, wr, wc, fr, fq);
        if (!has_next) break;
        if (!nxt.keep) {
#pragma unroll
        for (int a = 0; a < 2; ++a)
#pragma unroll
            for (int b = 0; b < 2; ++b)
#pragma unroll
                for (int m = 0; m < 4; ++m)
#pragma unroll
                    for (int n = 0; n < 2; ++n) acc[a][b][m][n] = (f32x4){0.f, 0.f, 0.f, 0.f};
        }
        cur = nxt; cA = nA; cB = nB; ++ui;
        if (wr == 1) PG8_BAR;
    }
    PG8_WAIT_V(0);
    PG8_BAR;
#undef PG8_SA
#undef PG8_SB
#undef PG8_STAGE
#undef PG8_LDA
#undef PG8_LDB
#undef PG8_MMA
#undef PG8_WAIT_V
#undef PG8_WAIT_L
#undef PG8_BAR
#undef PG8_SCHED
}

typedef const f32x4 (&AccRef)[2][2][4][2];

__device__ __forceinline__ void epi_act(AccRef acc, bf16_t* O, int ld, int act, int wr, int wc, int fr, int fq) {
#pragma unroll
    for (int ai = 0; ai < 2; ++ai)
#pragma unroll
        for (int m = 0; m < 4; ++m) { bf16_t* rowp = O + (size_t)(ai * HALF + wr * 64 + m * 16 + fr) * ld + wc * 32 + 8 * fq;
#pragma unroll
            for (int bj = 0; bj < 2; ++bj) { f32x4 v0 = acc[ai][bj][m][0], v1 = acc[ai][bj][m][1];
                if (act != 0) {
#pragma unroll
                    for (int e = 0; e < 4; ++e) { const float s0 = sigmoidf_(v0[e]), s1 = sigmoidf_(v1[e]); v0[e] = act == 1 ? v0[e] * s0 : s0; v1[e] = act == 1 ? v1[e] * s1 : s1; } }
                u32x4 w; w.x = cvt_pk_bf16(v0[0], v0[1]); w.y = cvt_pk_bf16(v0[2], v0[3]); w.z = cvt_pk_bf16(v1[0], v1[1]); w.w = cvt_pk_bf16(v1[2], v1[3]);
                *(u32x4*)(rowp + bj * HALF) = w; }
            if (m & 1) asm volatile("" ::: "memory"); }
}
__device__ __forceinline__ void epi_qk(AccRef acc, bf16_t* O, int ld, const float* g, const float* rope, int tok0, LAS float* X, int wr, int wc, int fr, int fq) {
#pragma unroll
    for (int ai = 0; ai < 2; ++ai)
#pragma unroll
        for (int m = 0; m < 4; ++m)
#pragma unroll
            for (int bj = 0; bj < 2; ++bj) { const f32x4 a = acc[ai][bj][m][0], b = acc[ai][bj][m][1];
                float s = (a[0] * a[0] + a[1] * a[1]) + (a[2] * a[2] + a[3] * a[3]) + (b[0] * b[0] + b[1] * b[1]) + (b[2] * b[2] + b[3] * b[3]);
                s += __shfl_xor(s, 16); s += __shfl_xor(s, 32);
                if (fq == 0) X[((ai * HALF + wr * 64 + m * 16 + fr) * 2 + bj) * 4 + wc] = s; }
    asm volatile("s_waitcnt lgkmcnt(0)" ::: "memory"); __builtin_amdgcn_s_barrier(); asm volatile("" ::: "memory");
    const int axis = wc >> 1, f0 = (wc & 1) * 16 + 4 * fq;
    const f32x4 g1 = *(const f32x4*)(g + axis * 64 + f0), g2 = *(const f32x4*)(g + axis * 64 + 32 + f0);
#pragma unroll
    for (int ai = 0; ai < 2; ++ai)
#pragma unroll
        for (int m = 0; m < 4; ++m) { const int rowl = ai * HALF + wr * 64 + m * 16 + fr;
            f32x4 cs0 = (f32x4){1.f, 0.f, 1.f, 0.f}, cs1 = cs0;
            if (rope) { const int n = tok0 + rowl, pos = axis ? (n & 63) : (n >> 6); const float* p = rope + (pos * 32 + f0) * 2; cs0 = *(const f32x4*)p; cs1 = *(const f32x4*)(p + 4); }
            const float co[4] = {cs0[0], cs0[2], cs1[0], cs1[2]}, si[4] = {cs0[1], cs0[3], cs1[1], cs1[3]};
#pragma unroll
            for (int bj = 0; bj < 2; ++bj) { const f32x4 part = *(const LAS f32x4*)(X + (rowl * 2 + bj) * 4);
                const float rstd = __builtin_amdgcn_rsqf(((part[0] + part[1]) + (part[2] + part[3])) * (1.f / 128.f) + EPS);
                const f32x4 x1 = acc[ai][bj][m][0] * rstd * g1, x2 = acc[ai][bj][m][1] * rstd * g2; float o1[4], o2[4];
#pragma unroll
                for (int e = 0; e < 4; ++e) { o1[e] = x1[e] * co[e] - x2[e] * si[e]; o2[e] = x2[e] * co[e] + x1[e] * si[e]; }
                u32x4 w; w.x = cvt_pk_bf16(o1[0], o1[1]); w.y = cvt_pk_bf16(o1[2], o1[3]); w.z = cvt_pk_bf16(o2[0], o2[1]); w.w = cvt_pk_bf16(o2[2], o2[3]);
                *(u32x4*)(O + (size_t)rowl * ld + bj * HALF + wc * 32 + 8 * fq) = w; }
            asm volatile("" ::: "memory"); }
}
__device__ __forceinline__ void epi_mul(AccRef acc, bf16_t* O, int ldo, const bf16_t* A1, int ld, int wr, int wc, int fr, int fq) {
#pragma unroll
    for (int ai = 0; ai < 2; ++ai)
#pragma unroll
        for (int m = 0; m < 4; ++m) { const int rl = ai * HALF + wr * 64 + m * 16 + fr, cl = wc * 32 + 8 * fq;
#pragma unroll
            for (int bj = 0; bj < 2; ++bj) { const u32x4 q1 = *(const u32x4*)(A1 + (size_t)rl * ld + cl + bj * HALF);
                f32x4 v0 = acc[ai][bj][m][0], v1 = acc[ai][bj][m][1];
                v0[0] *= bf_lo(q1.x); v0[1] *= bf_hi(q1.x); v0[2] *= bf_lo(q1.y); v0[3] *= bf_hi(q1.y); v1[0] *= bf_lo(q1.z); v1[1] *= bf_hi(q1.z); v1[2] *= bf_lo(q1.w); v1[3] *= bf_hi(q1.w);
                u32x4 w; w.x = cvt_pk_bf16(v0[0], v0[1]); w.y = cvt_pk_bf16(v0[2], v0[3]); w.z = cvt_pk_bf16(v1[0], v1[1]); w.w = cvt_pk_bf16(v1[2], v1[3]);
                *(u32x4*)(O + (size_t)rl * ldo + cl + bj * HALF) = w; }
            if (m == 3) asm volatile("" ::: "memory"); }
}
__device__ __forceinline__ void epi_ratio(f32x4 (&acc)[2][2][4][2], const bf16_t* GAo, const bf16_t* GBo, int wr, int wc, int fr, int fq) {
#pragma unroll
    for (int ai = 0; ai < 2; ++ai)
#pragma unroll
        for (int m = 0; m < 4; ++m) { const size_t ro = (size_t)(ai * HALF + wr * 64 + m * 16 + fr) * DM + wc * 32 + 8 * fq;
#pragma unroll
            for (int bj = 0; bj < 2; ++bj) { const u32x4 qa = *(const u32x4*)(GAo + ro + bj * HALF), qb = *(const u32x4*)(GBo + ro + bj * HALF);
                f32x4& v0 = acc[ai][bj][m][0]; f32x4& v1 = acc[ai][bj][m][1];
                v0[0] *= bf_lo(qb.x) * __builtin_amdgcn_rcpf(bf_lo(qa.x)); v0[1] *= bf_hi(qb.x) * __builtin_amdgcn_rcpf(bf_hi(qa.x));
                v0[2] *= bf_lo(qb.y) * __builtin_amdgcn_rcpf(bf_lo(qa.y)); v0[3] *= bf_hi(qb.y) * __builtin_amdgcn_rcpf(bf_hi(qa.y));
                v1[0] *= bf_lo(qb.z) * __builtin_amdgcn_rcpf(bf_lo(qa.z)); v1[1] *= bf_hi(qb.z) * __builtin_amdgcn_rcpf(bf_hi(qa.z));
                v1[2] *= bf_lo(qb.w) * __builtin_amdgcn_rcpf(bf_lo(qa.w)); v1[3] *= bf_hi(qb.w) * __builtin_amdgcn_rcpf(bf_hi(qa.w)); }
            if (m == 3) asm volatile("" ::: "memory"); }
}
__device__ __forceinline__ void epi_m1(f32x4 (&acc)[2][2][4][2], bf16_t* O, const bf16_t* NUM, const bf16_t* DEN, bool store, int wr, int wc, int fr, int fq) {
#pragma unroll
    for (int ai = 0; ai < 2; ++ai)
#pragma unroll
        for (int m = 0; m < 4; ++m) { const size_t ro = (size_t)(ai * HALF + wr * 64 + m * 16 + fr) * DM + wc * 32 + 8 * fq;
#pragma unroll
            for (int bj = 0; bj < 2; ++bj) { const u32x4 qn = *(const u32x4*)(NUM + ro + bj * HALF);
                float f[8] = {bf_lo(qn.x), bf_hi(qn.x), bf_lo(qn.y), bf_hi(qn.y), bf_lo(qn.z), bf_hi(qn.z), bf_lo(qn.w), bf_hi(qn.w)};
                if (DEN) { const u32x4 qd = *(const u32x4*)(DEN + ro + bj * HALF);
                    const float d[8] = {bf_lo(qd.x), bf_hi(qd.x), bf_lo(qd.y), bf_hi(qd.y), bf_lo(qd.z), bf_hi(qd.z), bf_lo(qd.w), bf_hi(qd.w)};
#pragma unroll
                    for (int e = 0; e < 8; ++e) f[e] *= __builtin_amdgcn_rcpf(d[e]); }
                f32x4& v0 = acc[ai][bj][m][0]; f32x4& v1 = acc[ai][bj][m][1];
                v0[0] *= f[0]; v0[1] *= f[1]; v0[2] *= f[2]; v0[3] *= f[3]; v1[0] *= f[4]; v1[1] *= f[5]; v1[2] *= f[6]; v1[3] *= f[7];
                if (store) { u32x4 w; w.x = cvt_pk_bf16(v0[0], v0[1]); w.y = cvt_pk_bf16(v0[2], v0[3]); w.z = cvt_pk_bf16(v1[0], v1[1]); w.w = cvt_pk_bf16(v1[2], v1[3]);
                    *(u32x4*)(O + ro + bj * HALF) = w; } }
            if (m == 3) asm volatile("" ::: "memory"); }
}
template <bool IN_BF>
__device__ __forceinline__ void epi_res(AccRef acc, bf16_t* O, const void* Xin, const float* gate, int wr, int wc, int fr, int fq) {
    f32x4 gv[2][2];
#pragma unroll
    for (int bj = 0; bj < 2; ++bj)
#pragma unroll
        for (int n = 0; n < 2; ++n) gv[bj][n] = *(const f32x4*)(gate + bj * HALF + wc * 32 + 8 * fq + 4 * n);
#pragma unroll
    for (int ai = 0; ai < 2; ++ai)
#pragma unroll
        for (int m = 0; m < 4; ++m) { const size_t ro = (size_t)(ai * HALF + wr * 64 + m * 16 + fr) * DM + wc * 32 + 8 * fq;
#pragma unroll
            for (int bj = 0; bj < 2; ++bj) { const size_t off = ro + bj * HALF; f32x4 x0, x1;
                if (IN_BF) { const u32x4 q = *(const u32x4*)((const bf16_t*)Xin + off); x0 = (f32x4){bf_lo(q.x), bf_hi(q.x), bf_lo(q.y), bf_hi(q.y)}; x1 = (f32x4){bf_lo(q.z), bf_hi(q.z), bf_lo(q.w), bf_hi(q.w)}; }
                else { x0 = *(const f32x4*)((const float*)Xin + off); x1 = *(const f32x4*)((const float*)Xin + off + 4); }
                const f32x4 o0 = x0 + gv[bj][0] * acc[ai][bj][m][0], o1 = x1 + gv[bj][1] * acc[ai][bj][m][1];
                u32x4 w; w.x = cvt_pk_bf16(o0[0], o0[1]); w.y = cvt_pk_bf16(o0[2], o0[3]); w.z = cvt_pk_bf16(o1[0], o1[1]); w.w = cvt_pk_bf16(o1[2], o1[3]);
                *(u32x4*)(O + off) = w; }
            if (m == 3) asm volatile("" ::: "memory"); }
}
__device__ __forceinline__ void epi_res_final(f32x4 (&acc)[2][2][4][2], const bf16_t* Xin, const float* gate, float* Fo, const float* fg, float* slots, unsigned* cnt, int pn, LAS float* PL, int wr, int wc, int fr, int fq) {
    int tid = threadIdx.x; asm volatile("" : "+v"(tid));
    const int wid = __builtin_amdgcn_readfirstlane(tid >> 6), lane = tid & 63;
    {   f32x4 gv[2][2];
#pragma unroll
        for (int bj = 0; bj < 2; ++bj)
#pragma unroll
            for (int n = 0; n < 2; ++n) gv[bj][n] = *(const f32x4*)(gate + bj * HALF + wc * 32 + 8 * fq + 4 * n);
#pragma unroll
        for (int ai = 0; ai < 2; ++ai)
#pragma unroll
            for (int m = 0; m < 4; ++m) { const size_t ro = (size_t)(ai * HALF + wr * 64 + m * 16 + fr) * DM + wc * 32 + 8 * fq; float s = 0.f;
#pragma unroll
                for (int bj = 0; bj < 2; ++bj) { const u32x4 q = *(const u32x4*)(Xin + ro + bj * HALF);
                    const f32x4 x0 = (f32x4){bf_lo(q.x), bf_hi(q.x), bf_lo(q.y), bf_hi(q.y)}, x1 = (f32x4){bf_lo(q.z), bf_hi(q.z), bf_lo(q.w), bf_hi(q.w)};
                    const f32x4 o0 = x0 + gv[bj][0] * acc[ai][bj][m][0], o1 = x1 + gv[bj][1] * acc[ai][bj][m][1];
                    acc[ai][bj][m][0] = o0; acc[ai][bj][m][1] = o1;
                    s += (o0[0] * o0[0] + o0[1] * o0[1]) + (o0[2] * o0[2] + o0[3] * o0[3]) + (o1[0] * o1[0] + o1[1] * o1[1]) + (o1[2] * o1[2] + o1[3] * o1[3]); }
                s += __shfl_xor(s, 16); s += __shfl_xor(s, 32);
                if (fq == 0) PL[(ai * HALF + wr * 64 + m * 16 + fr) * 4 + wc] = s;
                if (m == 3) asm volatile("" ::: "memory"); }
    }
    asm volatile("s_waitcnt lgkmcnt(0)" ::: "memory"); __builtin_amdgcn_s_barrier(); asm volatile("" ::: "memory");
    const int row = wid * 32 + (lane & 31);
    if (lane < 32) { const f32x4 p = *(const LAS f32x4*)(PL + row * 4); __hip_atomic_store(slots + row * 8 + pn, (p[0] + p[1]) + (p[2] + p[3]), __ATOMIC_RELAXED, __HIP_MEMORY_SCOPE_AGENT); }
    asm volatile("s_waitcnt vmcnt(0)" ::: "memory");
    if (lane == 0) (void)__hip_atomic_fetch_add(cnt, 1u, __ATOMIC_RELAXED, __HIP_MEMORY_SCOPE_AGENT);
    if (wid == 0) { unsigned sp = 0;
        while ((unsigned)__builtin_amdgcn_readfirstlane(__hip_atomic_load(cnt, __ATOMIC_RELAXED, __HIP_MEMORY_SCOPE_AGENT)) < 64u) { __builtin_amdgcn_s_sleep(2); if (++sp > (1u << 21)) break; }
        __builtin_amdgcn_fence(__ATOMIC_ACQUIRE, "agent"); }
    asm volatile("s_waitcnt vmcnt(0) lgkmcnt(0)" ::: "memory"); __builtin_amdgcn_s_barrier(); asm volatile("" ::: "memory");
    if (lane < 32) { float t = 0.f;
#pragma unroll
        for (int k = 0; k < 8; ++k) t += __hip_atomic_load(slots + row * 8 + k, __ATOMIC_RELAXED, __HIP_MEMORY_SCOPE_AGENT);
        PL[1024 + row] = __builtin_amdgcn_rsqf(t * (1.f / DM) + EPS); }
    asm volatile("s_waitcnt vmcnt(0) lgkmcnt(0)" ::: "memory"); __builtin_amdgcn_s_barrier(); asm volatile("" ::: "memory");
    {   f32x4 gf[2][2];
#pragma unroll
        for (int bj = 0; bj < 2; ++bj)
#pragma unroll
            for (int n = 0; n < 2; ++n) gf[bj][n] = *(const f32x4*)(fg + bj * HALF + wc * 32 + 8 * fq + 4 * n);
#pragma unroll
        for (int ai = 0; ai < 2; ++ai)
#pragma unroll
            for (int m = 0; m < 4; ++m) { const int rl = ai * HALF + wr * 64 + m * 16 + fr; const float rstd = PL[1024 + rl]; float* op = Fo + (size_t)rl * DM + wc * 32 + 8 * fq;
#pragma unroll
                for (int bj = 0; bj < 2; ++bj)
#pragma unroll
                    for (int n = 0; n < 2; ++n) *(f32x4*)(op + bj * HALF + 4 * n) = acc[ai][bj][m][n] * rstd * gf[bj][n]; }
    }
}
}

enum { KQ = 0, KK = 1, KACT = 2, KUB = 3 };
struct G1Sched {
    int Gq, cq, nM, nA, n1, n2, Lbase, Lend, split; const char* H; const char* W;
    __device__ __forceinline__ bool next(int i, pg8::Unit& u) const {
        if (cq < 0 || cq >= Gq) return false;
        int L = Lbase + i * Gq + cq; if (L >= Lend) return false;
        u.nt = DM / 64;
        if (L < nA) { int pm, j; pg8::tile_decode(L, nM, 18, pm, j); const int pn = ufl(j < 16 ? j : j + 4); pm = ufl(pm);
            u.kind = pn < 6 ? KQ : (pn < 8 ? KK : KACT); u.pm = pm; u.pn = pn; u.a = H + (size_t)pm * MiB; u.b = W + (size_t)pn * MiB; return true; }
        L -= nA;
        if (L < n1) { int pc, tt; pg8::tile_decode(L, 4, nM, pc, tt); pc = ufl(pc); tt = ufl(tt); u.kind = KUB; u.pm = pc; u.pn = tt; u.a = W + (size_t)(16 + pc) * MiB; u.b = H + (size_t)tt * MiB; return true; }
        L -= n1;
        if (L < n2) { const int pm = 32 + (L & 3), pn = 6 + (L >> 2); u.kind = pn < 8 ? KK : KACT; u.pm = pm; u.pn = pn; u.a = H + (size_t)pm * MiB; u.b = W + (size_t)pn * MiB; return true; }
        L -= n2;
        int pm, j, pn;
        if (!split) { pg8::tile_decode(L, nM, 16, pm, j); pn = 22 + j; }
        else if (L < (nM - 6) * 16) { pg8::tile_decode(L, nM - 6, 16, pm, j); pm += 6; pn = 22 + j; }
        else if (L < (nM - 6) * 16 + 8) { pm = 5; pn = 22 + (L - (nM - 6) * 16); }
        else if (L < (nM - 6) * 16 + 8 + 80) { pg8::tile_decode(L - (nM - 6) * 16 - 8, 5, 16, pm, j); pn = 22 + j; }
        else { pm = 5; pn = 30 + (L - (nM - 6) * 16 - 88); }
        pm = ufl(pm); pn = ufl(pn); u.kind = KACT; u.pm = pm; u.pn = pn; u.a = H + (size_t)pm * MiB; u.b = W + (size_t)pn * MiB; return true;
    }
};
struct G1Epi {
    static constexpr bool HAS_MID = false; static constexpr int MID_T = 0;
    unsigned char* ws; const float *qg, *kg; LAS float* X;
    __device__ __forceinline__ void operator()(pg8::AccRef acc, const pg8::Unit& u, int wr, int wc, int fr, int fq) const {
        asm volatile("" : "+v"(fr), "+v"(fq));
        const int pm = u.pm, pn = u.pn; const float* rope = (const float*)(ws + WS_TAB);
        if (u.kind == KQ) {
            pg8::epi_qk(acc, (bf16_t*)(ws + WS_Q) + (size_t)pm * 256 * 1536 + pn * 256, 1536, qg, pm < 32 ? rope : nullptr, (pm & 7) * 256, X, wr, wc, fr, fq);
        } else if (u.kind == KK) {
            const int kvrow0 = pm < 32 ? pm * 256 + (pm >> 3) * 256 : (pm - 32) * KEYS + SEQ;
            pg8::epi_qk(acc, (bf16_t*)(ws + WS_K) + (size_t)kvrow0 * 512 + (pn - 6) * 256, 512, kg, pm < 32 ? rope : nullptr, (pm & 7) * 256, X, wr, wc, fr, fq);
        } else {
            bf16_t* O; int ld, act = 0;
            if (u.kind == KUB) { const int cs = pm >> 1, chb = (pm & 1) * 256;
                if (pn < 32) { O = (bf16_t*)(ws + WS_UT) + ((size_t)((pn >> 3) * 512 + chb)) * 4096 + cs * 2048 + (pn & 7) * 256; ld = 4096; }
                else { O = (bf16_t*)(ws + WS_UTC) + ((size_t)((pn - 32) * 512 + chb)) * 512 + cs * 256; ld = 512; } }
            else if (pn < 10) { const int kvrow0 = pm < 32 ? pm * 256 + (pm >> 3) * 256 : (pm - 32) * KEYS + SEQ; O = (bf16_t*)(ws + WS_V) + (size_t)kvrow0 * 512 + (pn - 8) * 256; ld = 512; }
            else if (pn < 16) { O = (bf16_t*)(ws + WS_ZA) + (size_t)pm * 256 * 1536 + (pn - 10) * 256; ld = 1536; act = 1; }
            else if (pn < 22) { O = (bf16_t*)(ws + WS_ZB) + (size_t)pm * 256 * 512 + (pn - 20) * 256; ld = 512; act = 1; }
            else if (pn < 30) { O = (bf16_t*)(ws + WS_GA) + (size_t)pm * 256 * 2048 + (pn - 22) * 256; ld = 2048; act = 2; }
            else { O = (bf16_t*)(ws + WS_GB) + (size_t)pm * 256 * 2048 + (pn - 30) * 256; ld = 2048; act = 2; }
            pg8::epi_act(acc, O, ld, act, wr, wc, fr, fq);
        }
    }
};
struct GridSched {
    int G, c, nM, nN, nt; const char* A; const char* B; size_t astep, bstep;
    __device__ __forceinline__ bool next(int i, pg8::Unit& u) const {
        const int L = i * G + c; if (L >= nM * nN) return false;
        int pm, pn; pg8::tile_decode(L, nM, nN, pm, pn); pm = ufl(pm); pn = ufl(pn); u.kind = 0; u.nt = nt; u.pm = pm; u.pn = pn; u.a = A + (size_t)pm * astep; u.b = B + (size_t)pn * bstep; return true;
    }
};
struct FnSched {
    int G, c, cu0, nunits, ntn, nt; const char* A; const char* B; size_t astep, bstep, bbatch; int row_base, rows_per_b;
    __device__ __forceinline__ bool next(int i, pg8::Unit& u) const {
        const int L = ufl(i * G + ((c - cu0 + 4 * G) % G)); if (L >= nunits) return false;
        const int pn = L & 1, pmn = ufl((L >> 1) % ntn), b = ufl((L >> 1) / ntn);
        u.kind = 0; u.nt = nt; u.pm = row_base + b * rows_per_b + pmn * 256;   u.pn = pn; u.a = A + (size_t)pmn * astep; u.b = B + (size_t)b * bbatch + (size_t)pn * bstep; return true;
    }
};
struct FnEpi {
    static constexpr bool HAS_MID = false; static constexpr int MID_T = 0;
    bf16_t* ACAT; const bf16_t* ZB;
    __device__ __forceinline__ void operator()(pg8::AccRef acc, const pg8::Unit& u, int wr, int wc, int fr, int fq) const {
        asm volatile("" : "+v"(fr), "+v"(fq));
        pg8::epi_mul(acc, ACAT + (size_t)u.pm * DM + u.pn * 256, DM, ZB + (size_t)u.pm * 512 + u.pn * 256, 512, wr, wc, fr, fq);
    }
};
__device__ __forceinline__ void m1_sub(pg8::Unit& u, int pm, int pn, int sub, int odd, const char* A, const char* B) {
    const bool ybpart = (sub == 0) != (odd != 0);
    u.pm = pm; u.pn = pn; u.nt = ybpart ? 8 : 24; const size_t ko = ybpart ? 0 : 1024;
    u.a = A + (size_t)pm * MiB + ko; u.b = B + (size_t)pn * MiB + ko; u.keep = sub; u.kind = sub * 2 + odd;
}
struct M1Sched {
    int G, c, nM; const char* A; const char* B;
    __device__ __forceinline__ bool next(int i, pg8::Unit& u) const {
        const int L = (i >> 1) * G + c; if (L >= nM * 8) return false;
        int pm, pn; pg8::tile_decode(L, nM, 8, pm, pn); m1_sub(u, ufl(pm), ufl(pn), i & 1, c & 1, A, B); return true;
    }
};
struct M1Epi {
    static constexpr bool HAS_MID = false; static constexpr int MID_T = 0;
    bf16_t* MMo; const bf16_t* GA; const bf16_t* GB;
    __device__ __forceinline__ void operator()(f32x4 (&acc)[2][2][4][2], const pg8::Unit& u, int wr, int wc, int fr, int fq) const {
        asm volatile("" : "+v"(fr), "+v"(fq));
        const size_t o = (size_t)u.pm * 256 * DM + u.pn * 256;
        const bool odd = u.kind & 1, fin = u.kind >= 2;
        const bf16_t* num = (fin ? (odd ? GB : GA) : (odd ? GA : GB)) + o; const bf16_t* den = fin ? nullptr : (odd ? GB : GA) + o;
        pg8::epi_m1(acc, MMo + o, num, den, fin, wr, wc, fr, fq);
    }
};
struct CtxM1Sched {
    int cq; const char* A; const char* B;
    __device__ __forceinline__ bool next(int i, pg8::Unit& u) const {
        if (i > 1 || cq < 0 || cq >= 32) return false;
        m1_sub(u, 32 + (cq >> 3), cq & 7, i, cq & 1, A, B); return true;
    }
};
struct FoldSched {
    int G, c; const char* Tt; const char* Wub;
    __device__ __forceinline__ bool next(int i, pg8::Unit& u) const {
        const int L = i * G + c; if (L >= 64) return false;
        int two = 2; asm volatile("" : "+s"(two));
        u.kind = 0; u.nt = two; u.pm = L >> 3; u.pn = L & 7; u.a = Tt; u.b = Wub + (size_t)(L >> 3) * (512 * 1024) + (size_t)(L & 7) * 65536; return true;
    }
};
struct FoldEpi {
    static constexpr bool HAS_MID = false; static constexpr int MID_T = 0;
    unsigned char* ws;
    __device__ __forceinline__ void operator()(pg8::AccRef acc, const pg8::Unit& u, int wr, int wc, int fr, int fq) const {
        asm volatile("" : "+v"(fr), "+v"(fq));
        const int l2 = u.pm >> 2, g = u.pm & 3; bf16_t* WT = (bf16_t*)(ws + WS_WIN + (size_t)l2 * 38 * MiB) + (size_t)(4096 + g * 128) * DM + u.pn * 256;
#pragma unroll
        for (int ai = 0; ai < 2; ++ai)
#pragma unroll
            for (int m = 0; m < 4; ++m) { bf16_t* rowp = WT + (size_t)(ai * 512 + wr * 64 + m * 16 + fr) * DM + wc * 32 + 8 * fq;
#pragma unroll
                for (int bj = 0; bj < 2; ++bj) { const f32x4 v0 = acc[ai][bj][m][0], v1 = acc[ai][bj][m][1];
                    u32x4 w; w.x = cvt_pk_bf16(v0[0], v0[1]); w.y = cvt_pk_bf16(v0[2], v0[3]); w.z = cvt_pk_bf16(v1[0], v1[1]); w.w = cvt_pk_bf16(v1[2], v1[3]);
                    *(u32x4*)(rowp + bj * 128) = w; } }
    }
};
struct OSched {
    int G, c, nctx; const char* A; const char* B;
    __device__ __forceinline__ bool next(int i, pg8::Unit& u) const {
        int L = i * G + c;
        if (G == 256 && c < nctx && i < 2) L = (i == 0) ? 256 + c : c;
        if (L < 256) { int pm, pn; pg8::tile_decode(L, 32, 8, pm, pn); pm = ufl(pm); pn = ufl(pn); u.kind = 0; u.nt = 32; u.pm = pm; u.pn = pn; u.a = A + (size_t)pm * MiB; u.b = B + (size_t)pn * MiB; return true; }
        const int s = L - 256; if (s >= nctx) return false;
        const int ch = s & 3, pn = (s >> 2) & 7, pm = 32 + (s >> 5);
        u.kind = 1 + ch; u.nt = 8; u.pm = pm; u.pn = pn; u.a = A + (size_t)pm * MiB + ch * 1024; u.b = B + (size_t)pn * MiB + ch * 1024; return true;
    }
};
struct ResEpi {
    static constexpr bool HAS_MID = false; static constexpr int MID_T = 0;
    bf16_t* out; const void* xin; int in_bf; float* cs_out; const float* gate; int fuse; float* fout; const float* fg; unsigned char* ctl; LAS float* PL;
    __device__ __forceinline__ void operator()(f32x4 (&acc)[2][2][4][2], const pg8::Unit& u, int wr, int wc, int fr, int fq) const {
        if (fuse && u.kind == 0) { asm volatile("" : "+v"(fr), "+v"(fq)); const int pm = u.pm, pn = u.pn; const size_t o = (size_t)pm * 256 * DM + pn * 256;
            pg8::epi_res_final(acc, (const bf16_t*)xin + o, gate + (size_t)(pm >> 3) * 6144 + pn * 256, fout + o, fg + pn * 256, (float*)(ctl + 65536) + (size_t)pm * 256 * 8, (unsigned*)ctl + 4096 + 64 * pm, pn, PL, wr, wc, fr, fq); }
        else (*this)((pg8::AccRef)acc, u, wr, wc, fr, fq);
    }
    bf16_t* out_;
    __device__ __forceinline__ void operator()(pg8::AccRef acc, const pg8::Unit& u, int wr, int wc, int fr, int fq) const {
        asm volatile("" : "+v"(fr), "+v"(fq));
        const int pm = u.pm, pn = u.pn;
        if (u.kind == 0) { const size_t o = (size_t)pm * 256 * DM + pn * 256; const float* gt = gate + (size_t)(pm >> 3) * 6144 + pn * 256;
            if (in_bf) pg8::epi_res<true>(acc, out + o, (const bf16_t*)xin + o, gt, wr, wc, fr, fq); else pg8::epi_res<false>(acc, out + o, (const float*)xin + o, gt, wr, wc, fr, fq); }
        else { float* O = cs_out + (size_t)(u.kind - 1) * MC * DM + (size_t)(pm - 32) * 256 * DM + pn * 256; const float* gt = gate + (size_t)4 * 6144 + pn * 256;
#pragma unroll
            for (int bj = 0; bj < 2; ++bj)
#pragma unroll
                for (int n = 0; n < 2; ++n) { const f32x4 gv = *(const f32x4*)(gt + bj * 128 + wc * 32 + 8 * fq + 4 * n);
#pragma unroll
                    for (int ai = 0; ai < 2; ++ai)
#pragma unroll
                        for (int m = 0; m < 4; ++m) *(f32x4*)(O + (size_t)(ai * 128 + wr * 64 + m * 16 + fr) * DM + bj * 128 + wc * 32 + 8 * fq + 4 * n) = gv * acc[ai][bj][m][n]; }
        }
    }
};

namespace att {
constexpr int D = 128, NW = 8, QBLK = 32, KVBLK = 64;
constexpr float SCALE = 0.088388347648318440f;
constexpr float THR = 8.f;
constexpr int LDQ = 1536, LDK = 512, LDZ = 1536, LDO = 2048;
constexpr size_t SHM_V = KVBLK * D * 2, SHM_K = KVBLK * D * 2, SHM_ATTN = 2 * SHM_V + 2 * SHM_K + NW * 64 * 4;
#define KSWZ(row, colB) ((row) * 256 + ((colB) ^ (((row) & 7) << 4)))
#define SBAR() __builtin_amdgcn_sched_barrier(0)
__device__ __forceinline__ int crow(int r, int hi) { return (r & 3) + 8 * (r >> 2) + 4 * hi; }
__device__ __forceinline__ unsigned cvtpk(float lo, float hi) { unsigned r; asm volatile("v_cvt_pk_bf16_f32 %0, %1, %2" : "=v"(r) : "v"(lo), "v"(hi)); return r; }
__device__ __forceinline__ void partialSM(f32x16& p0, f32x16& p1, float& m_reg, float& mn, float& alpha) {
  constexpr float C = SCALE * 1.4426950408889634f;
  float pmax = p0[0]; for (int r = 1; r < 16; ++r) pmax = fmaxf(pmax, p0[r]); for (int r = 0; r < 16; ++r) pmax = fmaxf(pmax, p1[r]);
  { auto rr = __builtin_amdgcn_permlane32_swap(__float_as_uint(pmax), __float_as_uint(pmax), false, false);
    pmax = fmaxf(__uint_as_float(rr[0]), __uint_as_float(rr[1])); }
  if (__builtin_expect(__all(pmax - m_reg <= THR / SCALE), 1)) { mn = m_reg; alpha = 1.f; }
  else { mn = fmaxf(m_reg, pmax); alpha = __builtin_amdgcn_exp2f((m_reg - mn) * C); m_reg = mn; }
  float mnC = -mn * C;
  for (int r = 0; r < 16; ++r) p0[r] = fmaf(p0[r], C, mnC); for (int r = 0; r < 16; ++r) p1[r] = fmaf(p1[r], C, mnC);
  for (int r = 0; r < 16; ++r) p0[r] = __builtin_amdgcn_exp2f(p0[r]);
}
__device__ __forceinline__ void finishSM(f32x16& p0, f32x16& p1, float alpha, float& l_reg, bf16x8& pa0, bf16x8& pa1, bf16x8& pa2, bf16x8& pa3) {
  for (int r = 0; r < 16; ++r) p1[r] = __builtin_amdgcn_exp2f(p1[r]);
  float ps = 0; for (int r = 0; r < 16; ++r) ps += p0[r]; for (int r = 0; r < 16; ++r) ps += p1[r];
  { auto rr = __builtin_amdgcn_permlane32_swap(__float_as_uint(ps), __float_as_uint(ps), false, false);
    ps = __uint_as_float(rr[0]) + __uint_as_float(rr[1]); }
  l_reg = l_reg * alpha + ps;
#define PK4(P, BASE, OUT) do { unsigned a0 = cvtpk(P[BASE + 0], P[BASE + 1]), a1 = cvtpk(P[BASE + 2], P[BASE + 3]);   \
    unsigned b0 = cvtpk(P[BASE + 4], P[BASE + 5]), b1 = cvtpk(P[BASE + 6], P[BASE + 7]);                              \
    auto r0 = __builtin_amdgcn_permlane32_swap(a0, b0, false, false); auto r1 = __builtin_amdgcn_permlane32_swap(a1, b1, false, false); \
    u32x4 w = {r0[0], r1[0], r0[1], r1[1]}; OUT = *reinterpret_cast<bf16x8*>(&w); } while (0)
  PK4(p0, 0, pa0); PK4(p0, 8, pa1); PK4(p1, 0, pa2); PK4(p1, 8, pa3);
#undef PK4
}
__device__ __forceinline__ void qkt(f32x16& p0, f32x16& p1, const bf16_t* Ks, const bf16x8* qr, int r32, int hi) {
  p0 = f32x16{}; p1 = f32x16{};
  for (int d0 = 0; d0 < 8; ++d0) { int cb = (d0 * 16 + hi * 8) * 2;
    bf16x8 b0 = *reinterpret_cast<const bf16x8*>((const char*)Ks + KSWZ(r32, cb));
    bf16x8 b1 = *reinterpret_cast<const bf16x8*>((const char*)Ks + KSWZ(32 + r32, cb));
    p0 = __builtin_amdgcn_mfma_f32_32x32x16_bf16(b0, qr[d0], p0, 0, 0, 0);
    p1 = __builtin_amdgcn_mfma_f32_32x32x16_bf16(b1, qr[d0], p1, 0, 0, 0); }
}
__device__ __forceinline__ int v_st(int k, int c) { const int kk = (k & ~0xC) | ((k & 4) << 1) | ((k & 8) >> 1); return ((kk >> 3) * 4 + (c >> 5)) * 512 + ((kk & 7) * 32 + (c & 31)) * 2; }
__device__ __forceinline__ int v_rd_base(int lane) { return ((lane & 3) << 3) | (((lane >> 2) & 3) << 6) | (((lane >> 4) & 1) << 5) | (((lane >> 5) & 1) << 8); }
constexpr int v_rd_off(int d0, int ks, int half) { return d0 * 512 + ks * 4096 + half * 2048; }
template <int OFF> __device__ __forceinline__ s16x4 tr_read(int vb) {
  s16x4 r; asm volatile("ds_read_b64_tr_b16 %0, %1 offset:%2" : "=&v"(r) : "v"(vb), "i"(OFF) : "memory"); return r;
}
template <int D0> __device__ __forceinline__ void pv_one(f32x16& od, int vb, bf16x8 pa0, bf16x8 pa1, bf16x8 pa2, bf16x8 pa3) {
  const s16x4 l0 = tr_read<v_rd_off(D0, 0, 0)>(vb), h0 = tr_read<v_rd_off(D0, 0, 1)>(vb), l1 = tr_read<v_rd_off(D0, 1, 0)>(vb), h1 = tr_read<v_rd_off(D0, 1, 1)>(vb);
  const s16x4 l2 = tr_read<v_rd_off(D0, 2, 0)>(vb), h2 = tr_read<v_rd_off(D0, 2, 1)>(vb), l3 = tr_read<v_rd_off(D0, 3, 0)>(vb), h3 = tr_read<v_rd_off(D0, 3, 1)>(vb);
  asm volatile("s_waitcnt lgkmcnt(0)" ::: "memory"); SBAR();
#define PK(L, H) (bf16x8){L[0], L[1], L[2], L[3], H[0], H[1], H[2], H[3]}
  od = __builtin_amdgcn_mfma_f32_32x32x16_bf16(pa0, PK(l0, h0), od, 0, 0, 0);
  od = __builtin_amdgcn_mfma_f32_32x32x16_bf16(pa1, PK(l1, h1), od, 0, 0, 0);
  od = __builtin_amdgcn_mfma_f32_32x32x16_bf16(pa2, PK(l2, h2), od, 0, 0, 0);
  od = __builtin_amdgcn_mfma_f32_32x32x16_bf16(pa3, PK(l3, h3), od, 0, 0, 0);
#undef PK
}
__device__ __forceinline__ void pv_d0(f32x16* o, int vb, bf16x8 pa0, bf16x8 pa1, bf16x8 pa2, bf16x8 pa3) {
  pv_one<0>(o[0], vb, pa0, pa1, pa2, pa3); pv_one<1>(o[1], vb, pa0, pa1, pa2, pa3); pv_one<2>(o[2], vb, pa0, pa1, pa2, pa3); pv_one<3>(o[3], vb, pa0, pa1, pa2, pa3);
}
__device__ __forceinline__ void attn_dense_body(const bf16_t* __restrict__ Qb, const bf16_t* __restrict__ Kh, const bf16_t* __restrict__ Vh,
                                                const bf16_t* __restrict__ ZAb, bf16_t* __restrict__ AAb, int seq, char* lds) {
  int tid = threadIdx.x; asm volatile("" : "+v"(tid));
  const int wid = tid >> 6, lane = tid & 63, r32 = lane & 31, hi = lane >> 5;
  bf16_t* V_lds = (bf16_t*)lds; bf16_t* K_lds = (bf16_t*)(lds + 2 * SHM_V);
  float* ws = (float*)(lds + 2 * SHM_V + 2 * SHM_K) + wid * 64; float* li_l = ws; float* al_l = ws + 32;
  float m_reg = -1e30f, l_reg = 0; f32x16 o[4] = {}; bf16x8 qr[8];
  const bf16_t* Qw = Qb + (long)(wid * QBLK + r32) * LDQ + hi * 8;
#pragma unroll
  for (int d0 = 0; d0 < 8; ++d0) qr[d0] = *reinterpret_cast<const bf16x8*>(Qw + d0 * 16);
  const int sr = tid >> 4, sc = (tid & 15) * 8, vst0 = v_st(sr, sc), vst1 = v_st(32 + sr, sc);
  const int vb0 = (int)(uintptr_t)V_lds + v_rd_base(lane);
  struct { bf16x8 vs0, vs1, ks0, ks1; } sr_[2];
#define SLOAD(i, k0) do { sr_[i].vs0 = *reinterpret_cast<const bf16x8*>(&Vh[(long)((k0) + sr) * LDK + sc]); sr_[i].vs1 = *reinterpret_cast<const bf16x8*>(&Vh[(long)((k0) + 32 + sr) * LDK + sc]); \
    sr_[i].ks0 = *reinterpret_cast<const bf16x8*>(&Kh[(long)((k0) + sr) * LDK + sc]); sr_[i].ks1 = *reinterpret_cast<const bf16x8*>(&Kh[(long)((k0) + 32 + sr) * LDK + sc]); } while (0)
#define SWRITE(b, i) do { *(bf16x8*)((char*)V_lds + (b) * SHM_V + vst0) = sr_[i].vs0;          \
    *(bf16x8*)((char*)V_lds + (b) * SHM_V + vst1) = sr_[i].vs1; int kc = sc * 2;               \
    *(bf16x8*)((char*)K_lds + (b) * SHM_K + KSWZ(sr, kc)) = sr_[i].ks0;                       \
    *(bf16x8*)((char*)K_lds + (b) * SHM_K + KSWZ(32 + sr, kc)) = sr_[i].ks1; } while (0)
#define SWAIT() asm volatile("s_waitcnt vmcnt(4)" ::: "memory")
#define RESC(a) do { if (__any((a) < 1.f)) { if (hi == 0) al_l[r32] = (a); asm volatile("s_waitcnt lgkmcnt(0)" ::: "memory"); \
    for (int d = 0; d < 4; ++d) for (int r = 0; r < 16; ++r) o[d][r] *= al_l[crow(r, hi)]; } } while (0)
  f32x16 pA0, pA1, pB0, pB1; float mnA, mnB, alA, alB; bf16x8 pa0, pa1, pa2, pa3; const int NT = seq / KVBLK;
  constexpr int SE = 0, SO = 1;
  SLOAD(SE, 0); asm volatile("s_waitcnt vmcnt(0)" ::: "memory"); SWRITE(0, SE); __syncthreads();
  qkt(pA0, pA1, K_lds, qr, r32, hi); partialSM(pA0, pA1, m_reg, mnA, alA);
  SLOAD(SO, KVBLK); if (2 < NT) SLOAD(SE, 2 * KVBLK);
  SWAIT(); SWRITE(1, SO); __syncthreads();
  for (int j = 1; j + 1 < NT; j += 2) {
    SBAR(); qkt(pB0, pB1, (bf16_t*)((char*)K_lds + SHM_K), qr, r32, hi);
    finishSM(pA0, pA1, alA, l_reg, pa0, pa1, pa2, pa3); SBAR();
    SLOAD(SO, (j + 2) * KVBLK); SBAR();
    pv_d0(o, vb0, pa0, pa1, pa2, pa3); partialSM(pB0, pB1, m_reg, mnB, alB);
    __syncthreads(); SWAIT(); SWRITE(0, SE);
    RESC(alB); __syncthreads();
    SBAR(); qkt(pA0, pA1, K_lds, qr, r32, hi);
    finishSM(pB0, pB1, alB, l_reg, pa0, pa1, pa2, pa3); SBAR();
    if (j + 3 < NT) SLOAD(SE, (j + 3) * KVBLK); SBAR();
    pv_d0(o, vb0 + (int)SHM_V, pa0, pa1, pa2, pa3); partialSM(pA0, pA1, m_reg, mnA, alA);
    __syncthreads(); SWAIT(); SWRITE(1, SO);
    RESC(alA); __syncthreads();
  }
  SBAR(); qkt(pB0, pB1, (bf16_t*)((char*)K_lds + SHM_K), qr, r32, hi);
  finishSM(pA0, pA1, alA, l_reg, pa0, pa1, pa2, pa3); SBAR();
  pv_d0(o, vb0, pa0, pa1, pa2, pa3); partialSM(pB0, pB1, m_reg, mnB, alB);
  __syncthreads(); RESC(alB);
  finishSM(pB0, pB1, alB, l_reg, pa0, pa1, pa2, pa3); SBAR();
  pv_d0(o, vb0 + (int)SHM_V, pa0, pa1, pa2, pa3);
  if (hi == 0) li_l[r32] = l_reg; asm volatile("s_waitcnt lgkmcnt(0)" ::: "memory");
  float rli[16];
#pragma unroll
  for (int r = 0; r < 16; ++r) rli[r] = __builtin_amdgcn_rcpf(li_l[crow(r, hi)]);
  __syncthreads();
  { char* stg = lds + wid * 8192;
#pragma unroll
    for (int r = 0; r < 16; ++r) { const int orow = crow(r, hi);
#pragma unroll
      for (int d0 = 0; d0 < 4; ++d0) *(bf16_t*)(stg + orow * 256 + (d0 * 32 + r32) * 2) = (bf16_t)(cvtpk(o[d0][r] * rli[r], 0.f) & 0xffffu); }
    asm volatile("s_waitcnt lgkmcnt(0)" ::: "memory");
    int lane_ = lane; asm volatile("" : "+v"(lane_));
    const int rr = lane_ >> 4, ch = lane_ & 15;
#pragma unroll
    for (int i = 0; i < 8; ++i) { const int row = i * 4 + rr; const u32x4 ov = *(const u32x4*)(stg + row * 256 + ch * 16);
      const long gi = (long)(wid * QBLK + row) * LDO + ch * 8; const u32x4 z = *(const u32x4*)(ZAb + (long)(wid * QBLK + row) * LDZ + ch * 8); u32x4 w;
      w.x = cvtpk(bf_lo(ov.x) * bf_lo(z.x), bf_hi(ov.x) * bf_hi(z.x)); w.y = cvtpk(bf_lo(ov.y) * bf_lo(z.y), bf_hi(ov.y) * bf_hi(z.y));
      w.z = cvtpk(bf_lo(ov.z) * bf_lo(z.z), bf_hi(ov.z) * bf_hi(z.z)); w.w = cvtpk(bf_lo(ov.w) * bf_lo(z.w), bf_hi(ov.w) * bf_hi(z.w));
      *(u32x4*)(AAb + gi) = w; } }
#undef SLOAD
#undef SWRITE
#undef SWAIT
#undef RESC
}
#undef KSWZ
#undef SBAR
}


#define XB_TMO      128
#define XB_XCNT(j)  (256  + 64 * (j))
#define XB_XSUB(j)  (1280 + 64 * (j))
#define XB_XGEN(j)  (2304 + 64 * (j))
#define XB_TOP      3328
#define XB_TOPGEN   3392
#define XCD_BAR_WORDS 3456
#define XB_SPIN_CAP (1u << 18)
__device__ __forceinline__ unsigned xb_ld(unsigned* p)              { return __hip_atomic_load(p, __ATOMIC_RELAXED, __HIP_MEMORY_SCOPE_AGENT); }
__device__ __forceinline__ unsigned xb_add(unsigned* p, unsigned v) { return __hip_atomic_fetch_add(p, v, __ATOMIC_RELAXED, __HIP_MEMORY_SCOPE_AGENT); }
__device__ __forceinline__ unsigned xb_xcc_id() { return (unsigned)__builtin_amdgcn_s_getreg((3 << 11) | 20) & 0xFu; }
#define XB_SPIN(cond, bar) do { unsigned _sp = 0; while (cond) { __builtin_amdgcn_s_sleep(1); \
    if ((++_sp & 255u) == 0u) { if (xb_ld(&(bar)[XB_TMO])) break; if (_sp > XB_SPIN_CAP) { atomicAdd(&(bar)[XB_TMO], 1u); break; } } } } while (0)
struct XcdBarrier { unsigned* bar; unsigned x; volatile LAS unsigned* st; };
__device__ __forceinline__ XcdBarrier xcd_barrier_post(unsigned* bar, volatile LAS unsigned* st) {
    XcdBarrier b; b.bar = bar; b.x = xb_xcc_id(); b.st = st;
    if (threadIdx.x == 0) (void)xb_add(&bar[XB_XCNT(b.x)], 1u);
    return b;
}
__device__ __forceinline__ void xcd_barrier_complete(unsigned* bar, unsigned x, unsigned& nloc, unsigned& nx) {
    const unsigned G = gridDim.x * gridDim.y * gridDim.z;
    unsigned sum, cnt, mine, sp = 0u;
    for (;;) {
        sum = 0u; cnt = 0u; mine = 0u;
#pragma unroll
        for (unsigned j = 0; j < 16; ++j) { const unsigned c = xb_ld(&bar[XB_XCNT(j)]); sum += c; cnt += (c > 0u) ? 1u : 0u; mine = (j == x) ? c : mine; }
        if (sum == G) break;
        __builtin_amdgcn_s_sleep(1);
        if ((++sp & 255u) == 0u) { if (xb_ld(&bar[XB_TMO])) break; if (sp > XB_SPIN_CAP) { atomicAdd(&bar[XB_TMO], 1u); break; } }
    }
    nloc = mine > 0u ? mine : 1u; nx = cnt > 0u ? cnt : 1u;
}
__device__ __forceinline__ void xcd_barrier(const XcdBarrier& b) {
    asm volatile("s_waitcnt vmcnt(0)" ::: "memory");
    __syncthreads();
    if (threadIdx.x == 0) {
        unsigned* bar = b.bar;
        __builtin_amdgcn_s_waitcnt(0);
        unsigned nloc = b.st[0], nx = b.st[1];
        if (nloc == 0u) { xcd_barrier_complete(bar, b.x, nloc, nx); b.st[0] = nloc; b.st[1] = nx; }
        const unsigned old = xb_add(&bar[XB_XSUB(b.x)], 1u);
        const unsigned gen = old / nloc;
        if (old + 1u == (gen + 1u) * nloc) {
            __builtin_amdgcn_fence(__ATOMIC_RELEASE, "agent");
            asm volatile("s_waitcnt vmcnt(0)" ::: "memory");
            const unsigned og = xb_add(&bar[XB_TOP], 1u);
            const unsigned tg = og / nx;
            if (og + 1u == (tg + 1u) * nx) xb_add(&bar[XB_TOPGEN], 1u);
            else XB_SPIN(xb_ld(&bar[XB_TOPGEN]) == tg, bar);
            __builtin_amdgcn_fence(__ATOMIC_ACQUIRE, "agent");
            xb_add(&bar[XB_XGEN(b.x)], 1u);
            asm volatile("s_waitcnt vmcnt(0)" ::: "memory");
        } else {
            XB_SPIN(xb_ld(&bar[XB_XGEN(b.x)]) == gen, bar);
            __builtin_amdgcn_fence(__ATOMIC_ACQUIRE, "agent");
            asm volatile("s_waitcnt vmcnt(0)" ::: "memory");
        }
    }
    __syncthreads();
}

struct Args { const float* in[14]; float* out; unsigned char* ws; int ph_lo, ph_hi; };

__device__ __forceinline__ int winT_row(int n) {
    if (n < 2048) { const int hb = n & ~127, d = n & 127, axis = d >> 6, nn = (d >> 5) & 1, f = d & 31; const int wc = axis * 2 + (f >> 4), fq = (f >> 2) & 3, e = f & 3; return hb + wc * 32 + 8 * fq + 4 * nn + e; }
    if (n < 4096) return n;
    return n + 512;
}
template <bool PERMW>
__device__ __forceinline__ void p0_tr_load(const float* W, int N, int kb, int nb, int lane, f32x4 (&v)[8]) {
    const float* src = W + (size_t)(64 * kb + 8 * (lane & 7)) * N + 32 * nb + 4 * (lane >> 3);
#pragma unroll
    for (int e = 0; e < 8; ++e) v[e] = __builtin_nontemporal_load((const f32x4*)(src + (size_t)e * N));
}
template <bool PERMW>
__device__ __forceinline__ void p0_tr_store(bf16_t* WT, int K  , int kb, int nb, int lane, const f32x4 (&v)[8]) {
    const int kq = lane & 7, ng = lane >> 3;
#pragma unroll
    for (int j = 0; j < 4; ++j) { const int n = 32 * nb + 4 * ng + j, row = PERMW ? winT_row(n) : n;
        u32x4 o; o.x = cvt_pk_bf16(v[0][j], v[1][j]); o.y = cvt_pk_bf16(v[2][j], v[3][j]); o.z = cvt_pk_bf16(v[4][j], v[5][j]); o.w = cvt_pk_bf16(v[6][j], v[7][j]);
        *(u32x4*)(WT + (size_t)row * K + 64 * kb + 8 * kq) = o; }
}
struct TrItem { const float* W; bf16_t* WT; int K, N, kb, nb, perm; };
constexpr int TI_IN = 32 * 272, TI_PA = 24 * 64, TI_PB = 8 * 64, TI_O = 32 * 64, TI_L = TI_IN + TI_PA + TI_PB + TI_O;
__device__ __forceinline__ TrItem tr_decode(int it, const float* w_in, const float* w_pa, const float* w_pb, const float* w_out, unsigned char* ws) {
    TrItem t; const int l = it / TI_L; int r = it % TI_L;
    if (r < TI_IN) { const int kb = r / 272, nb0 = r % 272; t.W = w_in + (size_t)l * DM * INW; t.WT = (bf16_t*)(ws + WS_WIN + (size_t)l * 38 * MiB); t.K = DM; t.N = INW; t.kb = kb; t.nb = nb0 < 128 ? nb0 : nb0 + 16; t.perm = 1; return t; }
    r -= TI_IN;
    if (r < TI_PA) { t.W = w_pa + (size_t)l * 1536 * DM; t.WT = (bf16_t*)(ws + WS_WCAT + (size_t)l * 8 * MiB) + 512; t.K = DM; t.N = DM; t.kb = r / 64; t.nb = r % 64; t.perm = 0; return t; }
    r -= TI_PA;
    if (r < TI_PB) { t.W = w_pb + (size_t)l * 512 * DM; t.WT = (bf16_t*)(ws + WS_WCAT + (size_t)l * 8 * MiB); t.K = DM; t.N = DM; t.kb = r / 64; t.nb = r % 64; t.perm = 0; return t; }
    r -= TI_PB;
    t.W = w_out + (size_t)l * DM * DM; t.WT = (bf16_t*)(ws + WS_WO + (size_t)l * 8 * MiB); t.K = DM; t.N = DM; t.kb = r / 64; t.nb = r % 64; t.perm = 0; return t;
}

__global__ void __launch_bounds__(512, 2) mk_fwd(Args args) {
    extern __shared__ __attribute__((aligned(16))) unsigned char lds_raw[];
    LAS unsigned char* lds = (LAS unsigned char*)lds_raw;
    const int tid = threadIdx.x, lane = tid & 63, wave = __builtin_amdgcn_readfirstlane(tid >> 6);
    const int G = gridDim.x, cb = blockIdx.x;
    const int vcu = (G % 8 == 0) ? (cb % 8) * (G / 8) + cb / 8 : cb;
    unsigned char* ws = args.ws;
    const float *x = args.in[0], *cvec = args.in[1], *ctx = args.in[2], *c_ctx = args.in[3], *w_ada = args.in[4], *b_ada = args.in[5], *norm_g = args.in[6], *w_in = args.in[7],
                *q_norm_g = args.in[8], *k_norm_g = args.in[9], *w_pa = args.in[10], *w_pb = args.in[11], *w_out = args.in[12], *final_g = args.in[13];
    float* out = args.out;
    float* MOD = (float*)(ws + WS_MOD); float* ROPE = (float*)(ws + WS_TAB); bf16_t* DM256 = (bf16_t*)(ws + WS_TAB + 65536); bf16_t* DM2K = (bf16_t*)(ws + WS_DM);
    bf16_t *Hb = (bf16_t*)(ws + WS_H), *Qb = (bf16_t*)(ws + WS_Q), *Kb = (bf16_t*)(ws + WS_K), *Vb = (bf16_t*)(ws + WS_V), *ZA = (bf16_t*)(ws + WS_ZA), *ZB = (bf16_t*)(ws + WS_ZB),
           *GA = (bf16_t*)(ws + WS_GA), *GB = (bf16_t*)(ws + WS_GB), *UT = (bf16_t*)(ws + WS_UT), *UTC = (bf16_t*)(ws + WS_UTC), *ACAT = (bf16_t*)(ws + WS_ACAT), *MM = (bf16_t*)(ws + WS_MM);
    bf16_t* XS = (bf16_t*)(ws + WS_XS);
    const int lo = args.ph_lo, hi = args.ph_hi;
#ifndef PHMASK
#define PHMASK 0xffffu
#endif
#define PHON(k) (((PHMASK) >> ((k) > 5 && (k) < 11 ? (k) - 5 : (k))) & 1u)
#define IN(k) (PHON(k) && lo <= (k) && (k) < hi)
#if MK_XCD_BAR
    volatile LAS unsigned* MISC = (volatile LAS unsigned*)(lds + LDS_MISC);
    if (tid < 2) MISC[tid] = 0u;
    __syncthreads();
    XcdBarrier xbar; xbar.bar = (unsigned*)ws; xbar.x = 0; xbar.st = MISC;
    if (hi - lo > 1) xbar = xcd_barrier_post((unsigned*)ws, MISC);
    if (lo < 0) cg::this_grid().sync();
#define SEAM(k) do { if (IN(k) && IN((k) + 1)) { xcd_barrier(xbar); } } while (0)
#else
#define SEAM(k) do { if (IN(k) && IN((k) + 1)) { cg::this_grid().sync(); } } while (0)
#endif
    const int gw = vcu * 8 + wave, NGW = G * 8;

    for (int rep = 0; rep < NREP(0); ++rep)
    if (IN(0)) {
        const int tb0 = G == 256 ? 192 : 0, tbn = G - tb0;
        if (cb >= tb0) {
            LAS float* ctab = (LAS float*)lds;
            for (int i = tid; i < 2048; i += 512) ctab[i] = cospif((float)i * (1.f / 1024.f)) * 0.022097086912079608f;
            __syncthreads();
            for (int idx8 = (cb - tb0) * 512 + tid; idx8 < 2048 * 512; idx8 += tbn * 512) { const int n = idx8 >> 9, j0 = (idx8 & 511) * 8; float v[8];
#pragma unroll
                for (int e = 0; e < 8; ++e) { const int j = j0 + e; v[e] = j < 2048 ? ctab[(n * j) & 2047] : -ctab[(n * (j - 2048) - 512) & 2047]; }
                u32x4 o; o.x = cvt_pk_bf16(v[0], v[1]); o.y = cvt_pk_bf16(v[2], v[3]); o.z = cvt_pk_bf16(v[4], v[5]); o.w = cvt_pk_bf16(v[6], v[7]);
                *(u32x4*)(DM2K + (size_t)n * 4096 + j0) = o; }
            for (int idx8 = (cb - tb0) * 512 + tid; idx8 < 256 * 64; idx8 += tbn * 512) { const int n = idx8 >> 6, j0 = (idx8 & 63) * 8; float v[8];
#pragma unroll
                for (int e = 0; e < 8; ++e) { const int j = j0 + e; v[e] = 2.8284271247461903f * (j < 256 ? ctab[((n * j) & 255) * 8] : -ctab[((((n * (j - 256)) & 255) * 8) - 512) & 2047]); }
                u32x4 o; o.x = cvt_pk_bf16(v[0], v[1]); o.y = cvt_pk_bf16(v[2], v[3]); o.z = cvt_pk_bf16(v[4], v[5]); o.w = cvt_pk_bf16(v[6], v[7]);
                *(u32x4*)(DM256 + (size_t)n * 512 + j0) = o; }
            for (int idx = (cb - tb0) * 512 + tid; idx < 64 * 32; idx += tbn * 512) { const int pos = idx >> 5, f = idx & 31; const float inv = exp2f(-(float)f * (13.287712379549449f / 32.f)); const float ang = (float)pos * inv;
                ROPE[idx * 2] = cosf(ang); ROPE[idx * 2 + 1] = sinf(ang); }
            for (int idx8 = (cb - tb0) * 512 + tid; idx8 < 256 * 16; idx8 += tbn * 512) { const int jp = idx8 >> 4, c0 = (idx8 & 15) * 8, cp = jp & 127; float v[8];
#pragma unroll
                for (int e = 0; e < 8; ++e) { const float ph = (float)(((c0 + e) * cp) & 127) * (1.f / 64.f); v[e] = (jp < 128 ? cospif(ph) : sinpif(ph)) * 0.08838834764831845f; }
                u32x4 o; o.x = cvt_pk_bf16(v[0], v[1]); o.y = cvt_pk_bf16(v[2], v[3]); o.z = cvt_pk_bf16(v[4], v[5]); o.w = cvt_pk_bf16(v[6], v[7]);
                *(u32x4*)((bf16_t*)(ws + WS_TT) + jp * 128 + c0) = o; }
            __syncthreads();
        }
        {
            LAS float* sc = (LAS float*)lds;
            LAS float* part = (LAS float*)(lds + 40960);
            for (int idx = tid; idx < 5 * 2048; idx += 512) { const int r = idx >> 11, k = idx & 2047; const float v = r < 4 ? cvec[r * 2048 + k] : c_ctx[k]; sc[idx] = v * sigmoidf_(v); }
            __syncthreads();
            for (int item = cb; item < 192; item += G) {
                const int l = item / 96, cc = item % 96, cg4 = lane & 15, kp = lane >> 4;
                const float* wp = w_ada + ((size_t)l * 2048 + wave * 256 + kp) * 6144 + cc * 64 + cg4 * 4;
                f32x4 a0 = {0.f, 0.f, 0.f, 0.f}, a1 = a0, a2 = a0, a3 = a0, a4 = a0;
#pragma unroll 8
                for (int i = 0; i < 64; ++i) { const f32x4 w = *(const f32x4*)(wp + (size_t)i * 4 * 6144); const int k = wave * 256 + 4 * i + kp;
                    a0 += w * sc[k]; a1 += w * sc[2048 + k]; a2 += w * sc[4096 + k]; a3 += w * sc[6144 + k]; a4 += w * sc[8192 + k]; }
#pragma unroll
                for (int e = 0; e < 4; ++e) { a0[e] += __shfl_xor(a0[e], 16); a0[e] += __shfl_xor(a0[e], 32); a1[e] += __shfl_xor(a1[e], 16); a1[e] += __shfl_xor(a1[e], 32);
                    a2[e] += __shfl_xor(a2[e], 16); a2[e] += __shfl_xor(a2[e], 32); a3[e] += __shfl_xor(a3[e], 16); a3[e] += __shfl_xor(a3[e], 32); a4[e] += __shfl_xor(a4[e], 16); a4[e] += __shfl_xor(a4[e], 32); }
                if (kp == 0) { LAS float* pp = part + wave * 320 + cg4 * 4;
                    *(LAS f32x4*)(pp) = a0; *(LAS f32x4*)(pp + 64) = a1; *(LAS f32x4*)(pp + 128) = a2; *(LAS f32x4*)(pp + 192) = a3; *(LAS f32x4*)(pp + 256) = a4; }
                __syncthreads();
                if (tid < 320) { const int r = tid >> 6, j = tid & 63; float s = b_ada[l * 6144 + cc * 64 + j];
#pragma unroll
                    for (int w = 0; w < 8; ++w) s += part[w * 320 + r * 64 + j];
                    MOD[((size_t)l * 5 + r) * 6144 + cc * 64 + j] = s; }
                __syncthreads();
            }
            __syncthreads();
        }
        {
            for (int it = gw; it < 2 * TI_L; it += 2 * NGW) {
                const TrItem t0 = tr_decode(it, w_in, w_pa, w_pb, w_out, ws); const bool two = it + NGW < 2 * TI_L;
                const TrItem t1 = tr_decode(two ? it + NGW : it, w_in, w_pa, w_pb, w_out, ws);
                f32x4 v0[8], v1[8];
                p0_tr_load<false>(t0.W, t0.N, t0.kb, t0.nb, lane, v0);
                if (two) p0_tr_load<false>(t1.W, t1.N, t1.kb, t1.nb, lane, v1);
                if (t0.perm) p0_tr_store<true>(t0.WT, t0.K, t0.kb, t0.nb, lane, v0); else p0_tr_store<false>(t0.WT, t0.K, t0.kb, t0.nb, lane, v0);
                if (two) { if (t1.perm) p0_tr_store<true>(t1.WT, t1.K, t1.kb, t1.nb, lane, v1); else p0_tr_store<false>(t1.WT, t1.K, t1.kb, t1.nb, lane, v1); }
            }
            __syncthreads();
        }
        {
            bf16_t* WUB = (bf16_t*)(ws + WS_WUB);
            for (int idx8 = cb * 512 + tid; idx8 < 2 * 4 * 2048 * 16; idx8 += G * 512) { const int e = idx8 * 8, c0 = e & 127, k = (e >> 7) & 2047, g = (e >> 18) & 3, l2 = e >> 20;
                const float* src = w_in + ((size_t)l2 * DM + k) * INW + 4096 + g * 128 + c0; const f32x4 a = *(const f32x4*)src, b = *(const f32x4*)(src + 4);
                u32x4 o; o.x = cvt_pk_bf16(a[0], a[1]); o.y = cvt_pk_bf16(a[2], a[3]); o.z = cvt_pk_bf16(b[0], b[1]); o.w = cvt_pk_bf16(b[2], b[3]);
                *(u32x4*)(WUB + e) = o; }
        }
    }
    SEAM(0);

    const bool handoff = (G == 256 && hi - lo > 1);
    const bool fuse_final = (G == 256 && hi - lo > 1);
    for (int l = 0; l < 2; ++l) {
        const int P = 1 + 5 * l;
        const float* modl = MOD + (size_t)l * 5 * 6144;
        const int nM = l == 0 ? 36 : 32;
        for (int rep = 0; rep < NREP(P + 0); ++rep)
        if (IN(P)) {
            int lane = tid & 63; asm volatile("" : "+v"(lane));
            const float* xs = x; const float* cs = ctx; const float* PART = (const float*)(ws + WS_PART); const float* gn = norm_g + l * DM;
            const bool foldcu = (l == 0 && G == 256);
            const int r0 = foldcu ? (vcu >= 64 ? (vcu - 64) * 8 + wave : MT) : gw, rstep = foldcu ? 192 * 8 : NGW;
            const bool nbal = (l == 1 && G == 256);
            const int kmax = nbal ? 5 : (r0 < MT ? (MT - r0 + rstep - 1) / rstep : 0);
            for (int k = 0; k < kmax; ++k) {
                int r;
                if (nbal) { if (gw < 1024) { if (k == 4) continue; r = k == 0 ? ML + gw : gw + (k - 1) * 1024; } else r = 3072 + (gw - 1024) + k * 1024; }
                else r = r0 + k * rstep;
                const float* src = r < ML ? xs + (size_t)r * DM : cs + (size_t)(r - ML) * DM;
                const float* mrow = modl + (size_t)(r < ML ? (r >> 11) : 4) * 6144;
                f32x4 v[8]; float ss = 0.f;
#pragma unroll
                for (int j = 0; j < 8; ++j) v[j] = (f32x4){0.f, 0.f, 0.f, 0.f};
                if (!(l == 1 && r < ML)) {
#pragma unroll
                    for (int j = 0; j < 8; ++j) v[j] = *(const f32x4*)(src + j * 256 + lane * 4); }
                else {
#pragma unroll
                    for (int j = 0; j < 8; ++j) { const u32x2 q = *(const u32x2*)(XS + (size_t)r * DM + j * 256 + lane * 4); v[j] = (f32x4){bf_lo(q.x), bf_hi(q.x), bf_lo(q.y), bf_hi(q.y)}; } }
                if (l == 1 && r >= ML) {
                    const float* pp = PART + (size_t)(r - ML) * DM + lane * 4;
#pragma unroll
                    for (int ch = 0; ch < 4; ++ch)
#pragma unroll
                        for (int j = 0; j < 8; ++j) v[j] += *(const f32x4*)(pp + (size_t)ch * MC * DM + j * 256); }
#pragma unroll
                for (int j = 0; j < 8; ++j) ss += (v[j][0] * v[j][0] + v[j][1] * v[j][1]) + (v[j][2] * v[j][2] + v[j][3] * v[j][3]);
                const float rstd = __builtin_amdgcn_rsqf(wave_sum(ss) * (1.f / DM) + EPS);
#pragma unroll
                for (int j = 0; j < 8; ++j) { const int col = j * 256 + lane * 4; const f32x4 g = *(const f32x4*)(gn + col), sh = *(const f32x4*)(mrow + col), sl = *(const f32x4*)(mrow + 2048 + col);
                    const f32x4 h = (v[j] * rstd * g) * (sl + 1.f) + sh; u32x2 w; w.x = cvt_pk_bf16(h[0], h[1]); w.y = cvt_pk_bf16(h[2], h[3]);
                    *(u32x2*)(Hb + (size_t)r * DM + col) = w; }
            }
            if (l == 0) {
                __syncthreads();
                FoldSched S; S.G = G; S.c = vcu; S.Tt = (const char*)(ws + WS_TT); S.Wub = (const char*)(ws + WS_WUB);
                FoldEpi E; E.ws = ws; pg8::gemm_phase(lds, 128, S, E);
            }
        }
        SEAM(P);
        for (int rep = 0; rep < NREP(P + 1); ++rep)
        if (IN(P + 1)) {
            G1Sched S; S.Gq = G; S.cq = cb; S.nM = nM; S.nA = nM * 18; S.n1 = 4 * nM; S.n2 = l == 0 ? 0 : 16; S.Lbase = 0;
            S.split = (l == 0 && G == 256) ? 1 : 0;
            { const int tot = S.nA + S.n1 + S.n2 + nM * 16; S.Lend = (l == 0 && G == 256) ? 1280 : tot; }
            S.H = (const char*)Hb; S.W = (const char*)(ws + WS_WIN + (size_t)l * 38 * MiB);
            G1Epi E; E.ws = ws; E.qg = q_norm_g + l * 128; E.kg = k_norm_g + l * 128; E.X = (LAS float*)(lds + LDS_X);
            pg8::gemm_phase(lds, DM, S, E);
        }
        SEAM(P + 1);
        for (int rep = 0; rep < NREP(P + 2); ++rep)
        if (IN(P + 2)) {
            const int nun = l == 0 ? 384 + 48 : 384;
#ifndef NO_ATT
            const int astride = (l == 1 && G == 256) ? 192 : G;
            const bool ctxm1 = (l == 0 && G == 256 && hi - lo > 1);
            const int nk = ctxm1 ? 3 : (nun + astride - 1) / astride + 1;
            for (int k = 0; k < nk; ++k) {
                int a;
                if (ctxm1) a = (k == 0) ? (vcu < 48 ? 384 + vcu : -1) : (vcu + (k - 1) * 256 < 384 ? vcu + (k - 1) * 256 : -1);
                else { a = vcu < astride ? vcu + k * astride : -1; if (a >= nun) a = -1; }
                if (a < 0) continue;
                __syncthreads();
                size_t qo, ko, ao; int seq;
                if (a < 384) { const int bk = a / 24, hq = (a % 24) >> 3, qb = a & 7, b = bk >> 2, kvh = bk & 3, h = kvh * 3 + hq;
                    qo = ((size_t)b * SEQ + qb * 256) * 1536 + h * 128; ao = ((size_t)b * SEQ + qb * 256) * DM + 512 + h * 128; ko = (size_t)b * KEYS * 512 + kvh * 128; seq = KEYS;
                } else { const int a2 = a - 384, b = a2 / 12, h = a2 % 12, kvh = h / 3;
                    qo = ((size_t)ML + b * CTX) * 1536 + h * 128; ao = ((size_t)ML + b * CTX) * DM + 512 + h * 128; ko = ((size_t)b * KEYS + SEQ) * 512 + kvh * 128; seq = CTX; }
                qo = ufl64(qo); ko = ufl64(ko); ao = ufl64(ao); seq = ufl(seq);
                att::attn_dense_body(Qb + qo, Kb + ko, Vb + ko, ZA + qo, ACAT + ao, seq, (char*)lds_raw);
                if (ctxm1 && a >= 384) {
                    asm volatile("s_waitcnt vmcnt(0)" ::: "memory"); __syncthreads();
                    if (tid == 0) { __builtin_amdgcn_fence(__ATOMIC_RELEASE, "agent"); asm volatile("s_waitcnt vmcnt(0)" ::: "memory");
                        (void)__hip_atomic_fetch_add((unsigned*)ws + CW_CTXCNT, 1u, __ATOMIC_RELAXED, __HIP_MEMORY_SCOPE_AGENT); }
                }
            }
#endif
            __syncthreads();
#ifndef NO_FN
            { FnSched S; S.G = G; S.c = vcu; S.cu0 = G >= 256 ? 192 : 0; S.nunits = 64; S.ntn = 8; S.nt = 64; S.A = (const char*)DM2K; S.B = (const char*)UT; S.astep = 2 * MiB; S.bstep = 2 * MiB; S.bbatch = 4 * MiB; S.row_base = 0; S.rows_per_b = SEQ;
              FnEpi E; E.ACAT = ACAT; E.ZB = ZB; pg8::gemm_phase(lds, 4096, S, E); }
            if (l == 0) { FnSched S; S.G = G; S.c = vcu; S.cu0 = G >= 256 ? 176 : 0; S.nunits = 8; S.ntn = 1; S.nt = 8; S.A = (const char*)DM256; S.B = (const char*)UTC; S.astep = 0; S.bstep = MiB / 4; S.bbatch = MiB / 2; S.row_base = ML; S.rows_per_b = CTX;
              FnEpi E; E.ACAT = ACAT; E.ZB = ZB; pg8::gemm_phase(lds, 512, S, E); }
#endif
            if (ctxm1 && vcu >= 176 && vcu < 184) {
                asm volatile("s_waitcnt vmcnt(0)" ::: "memory"); __syncthreads();
                if (tid == 0) { __builtin_amdgcn_fence(__ATOMIC_RELEASE, "agent"); asm volatile("s_waitcnt vmcnt(0)" ::: "memory");
                    (void)__hip_atomic_fetch_add((unsigned*)ws + CW_CTXCNT, 1u, __ATOMIC_RELAXED, __HIP_MEMORY_SCOPE_AGENT); }
            }
            if (l == 0 && G == 256) {
                G1Sched S; S.Gq = 64; S.cq = (vcu >= 160 && vcu < 176) ? vcu - 160 : (vcu >= 184 && vcu < 192) ? 16 + vcu - 184 : (vcu >= 128 && vcu < 160) ? 24 + vcu - 128 : (vcu >= 176 && vcu < 184) ? 56 + vcu - 176 : -1; S.nM = nM; S.nA = nM * 18; S.n1 = 4 * nM; S.n2 = 0; S.Lbase = 1280; S.Lend = S.nA + S.n1 + nM * 16; S.split = 1;
                S.H = (const char*)Hb; S.W = (const char*)(ws + WS_WIN);
                G1Epi E; E.ws = ws; E.qg = q_norm_g; E.kg = k_norm_g; E.X = (LAS float*)(lds + LDS_X);
                pg8::gemm_phase(lds, DM, S, E);
            }
            if (ctxm1 && vcu >= 128 && vcu < 160) {
                if (tid == 0) { unsigned sp = 0;
                    while (__hip_atomic_load((unsigned*)ws + CW_CTXCNT, __ATOMIC_RELAXED, __HIP_MEMORY_SCOPE_AGENT) < 56u) { __builtin_amdgcn_s_sleep(2); if (++sp > (1u << 22)) break; }
                    __builtin_amdgcn_fence(__ATOMIC_ACQUIRE, "agent"); asm volatile("s_waitcnt vmcnt(0)" ::: "memory"); }
                __syncthreads();
                CtxM1Sched S; S.cq = vcu - 128; S.A = (const char*)ACAT; S.B = (const char*)(ws + WS_WCAT);
                M1Epi E; E.MMo = MM; E.GA = GA; E.GB = GB; pg8::gemm_phase(lds, DM, S, E);
            }
        }
        SEAM(P + 2);
        for (int rep = 0; rep < NREP(P + 3); ++rep)
        if (IN(P + 3)) {
            M1Sched S; S.G = G; S.c = cb; S.nM = (l == 0 && G == 256 && hi - lo > 1) ? 32 : nM; S.A = (const char*)ACAT; S.B = (const char*)(ws + WS_WCAT + (size_t)l * 8 * MiB);
            M1Epi E; E.MMo = MM; E.GA = GA; E.GB = GB; pg8::gemm_phase(lds, DM, S, E);
            if (handoff) {
                int pm_, pn_; pg8::tile_decode(cb, 32, 8, pm_, pn_); pm_ = ufl(pm_);
                asm volatile("s_waitcnt vmcnt(0)" ::: "memory"); __syncthreads();
                if (tid == 0) { __builtin_amdgcn_fence(__ATOMIC_RELEASE, "agent"); asm volatile("s_waitcnt vmcnt(0)" ::: "memory");
                    (void)__hip_atomic_fetch_add((unsigned*)ws + 6144 + 64 * (l * 32 + pm_), 1u, __ATOMIC_RELAXED, __HIP_MEMORY_SCOPE_AGENT); }
            }
        }
        if (!handoff) SEAM(P + 3);
        for (int rep = 0; rep < NREP(P + 4); ++rep)
        if (IN(P + 4)) {
            if (handoff) {
                int pm_, pn_; pg8::tile_decode(cb, 32, 8, pm_, pn_); pm_ = ufl(pm_);
                if (tid == 0) { unsigned sp = 0;
                    while (__hip_atomic_load((unsigned*)ws + 6144 + 64 * (l * 32 + pm_), __ATOMIC_RELAXED, __HIP_MEMORY_SCOPE_AGENT) < 8u) { __builtin_amdgcn_s_sleep(1); if (++sp > (1u << 22)) break; }
                    __builtin_amdgcn_fence(__ATOMIC_ACQUIRE, "agent"); asm volatile("s_waitcnt vmcnt(0)" ::: "memory"); }
                __syncthreads();
            }
            OSched S; S.G = G; S.c = cb; S.nctx = l == 0 ? 128 : 0; S.A = (const char*)MM; S.B = (const char*)(ws + WS_WO + (size_t)l * 8 * MiB);
            ResEpi E; E.out = XS; E.xin = l == 0 ? (const void*)x : (const void*)XS; E.in_bf = l; E.cs_out = (float*)(ws + WS_PART); E.gate = modl + 4096; E.fuse = (l == 1 && fuse_final) ? 1 : 0; E.fout = out; E.fg = final_g; E.ctl = ws; E.PL = (LAS float*)(lds + LDS_X); pg8::gemm_phase(lds, DM, S, E);
        }
        if (!(l == 1 && fuse_final)) SEAM(P + 4);
    }
    if (IN(11) && !fuse_final) {
        for (int r = gw; r < ML; r += NGW) {
            float* src = out + (size_t)r * DM; f32x4 v[8]; float ss = 0.f;
#pragma unroll
            for (int j = 0; j < 8; ++j) { const u32x2 q = *(const u32x2*)(XS + (size_t)r * DM + j * 256 + lane * 4); v[j] = (f32x4){bf_lo(q.x), bf_hi(q.x), bf_lo(q.y), bf_hi(q.y)};
                ss += (v[j][0] * v[j][0] + v[j][1] * v[j][1]) + (v[j][2] * v[j][2] + v[j][3] * v[j][3]); }
            const float rstd = __builtin_amdgcn_rsqf(wave_sum(ss) * (1.f / DM) + EPS);
#pragma unroll
            for (int j = 0; j < 8; ++j) { const int col = j * 256 + lane * 4; const f32x4 g = *(const f32x4*)(final_g + col); f32x4 o = v[j] * rstd * g;
                *(f32x4*)(src + col) = o; }
        }
    }
#undef IN
#undef SEAM
}

extern "C" void kernel_launch(void* const* d_in, const int* in_sizes, int n_in, void* d_out, int out_size, void* d_ws, size_t ws_size, hipStream_t stream) {
    static int grid = 0;
    if (grid == 0) {
        if (n_in != 14 || in_sizes[0] != ML * DM || out_size != ML * DM || ws_size < WS_END) { fprintf(stderr, "kernel_launch: unexpected shapes (n_in %d, in0 %d, out %d, ws %zu < %zu)\n", n_in, n_in > 0 ? in_sizes[0] : -1, out_size, ws_size, (size_t)WS_END); grid = -1; return; }
        int dev = 0, cus = 0, per_cu = 0;
        hipGetDevice(&dev); hipDeviceGetAttribute(&cus, hipDeviceAttributeMultiprocessorCount, dev);
        if (hipFuncSetAttribute((const void*)mk_fwd, hipFuncAttributeMaxDynamicSharedMemorySize, LDS_BYTES) != hipSuccess) { fprintf(stderr, "kernel_launch: hipFuncSetAttribute failed\n"); grid = -1; return; }
        if (hipOccupancyMaxActiveBlocksPerMultiprocessor(&per_cu, (const void*)mk_fwd, 512, LDS_BYTES) != hipSuccess || per_cu < 1) { fprintf(stderr, "kernel_launch: occupancy query says %d\n", per_cu); per_cu = 1; }
        (void)hipGetLastError();
        grid = cus > 0 ? cus : 256;
    }
    if (grid < 0) return;
    Args a{};
    for (int i = 0; i < 14; ++i) a.in[i] = (const float*)d_in[i];
    a.out = (float*)d_out; a.ws = (unsigned char*)d_ws;
#if MK_ONE_LAUNCH
    if (hipMemsetAsync(d_ws, 0, 49152, stream) != hipSuccess) { fprintf(stderr, "kernel_launch: memset of the control words failed\n"); return; }
    a.ph_lo = 0; a.ph_hi = NPH;
    void* kargs[] = {&a};
    hipError_t e = hipLaunchCooperativeKernel((const void*)mk_fwd, dim3(grid), dim3(512), kargs, LDS_BYTES, stream);
    if (e != hipSuccess) fprintf(stderr, "kernel_launch: cooperative launch failed: %s (grid %d)\n", hipGetErrorString(e), grid);
#else
    for (int p = 0; p < NPH; ++p) {
        a.ph_lo = p; a.ph_hi = p + 1;
        hipLaunchKernelGGL(mk_fwd, dim3(grid), dim3(512), LDS_BYTES, stream, a);
    }
    hipError_t e = hipPeekAtLastError();
    if (e != hipSuccess) fprintf(stderr, "kernel_launch: launch failed: %s\n", hipGetErrorName(e));
#endif
}
```
